# Optimizing an MI355X kernel written in HIP

```python
import jax, jax.numpy as jnp
from jax import lax
import numpy as np

D_MODEL = 1024
BATCH = 8
SEQ = 2048
DEPTH = 1
DEC_BATCH = 128
DEC_SEQ = 8
PAST_LEN = 8192
PAGE_SIZE = 128

D_CONV = D_MODEL
CONV_WIDTH = 3
HEAD_DIM = 64
N_HEADS = D_MODEL // HEAD_DIM
N_KV_HEADS = 4
GROUP = N_HEADS // N_KV_HEADS
WINDOW = 128
BLOCK = WINDOW
D_FF = 2816
Q_WIDTH = N_HEADS * HEAD_DIM
KV_WIDTH = N_KV_HEADS * HEAD_DIM
IN_WIDTH = 3 * D_CONV + Q_WIDTH + 2 * KV_WIDTH + 2 * D_MODEL
RMS_EPS = 1e-6
NEG_INF = -1e30

kernel_name = 'hybrid_conv_swa_sink_convffn_adaln_step'


def _rmsnorm(x, g):
    x32 = x.astype(jnp.float32)
    y = x32 * lax.rsqrt(jnp.mean(x32 * x32, axis=-1, keepdims=True) + RMS_EPS)
    return (y * g.astype(jnp.float32)).astype(x.dtype)


def _causal_conv(u, buf, w):
    t = u.shape[1]
    full = jnp.concatenate([buf.astype(u.dtype), u], axis=1)
    y = full[:, 0:t] * w[0]
    for tap in range(1, CONV_WIDTH):
        y = y + full[:, tap:tap + t] * w[tap]
    return y, full[:, t:]


def _alibi_slopes():
    h = jnp.arange(1, N_HEADS + 1, dtype=jnp.float32)
    return jnp.exp2(-8.0 * h / N_HEADS).reshape(N_KV_HEADS, GROUP)


def _sink_attend(q, k, v, dist, valid, sinks):
    s = jnp.einsum('...qhgd,...khd->...hgqk', q, k).astype(jnp.float32) * (HEAD_DIM ** -0.5)
    s = s - _alibi_slopes()[:, :, None, None] * dist[..., None, None, :, :]
    s = jnp.where(valid[..., None, None, :, :], s, NEG_INF)
    sink = sinks.astype(jnp.float32)[:, :, None, None]
    m = jnp.maximum(jnp.max(s, axis=-1, keepdims=True), sink)
    p = jnp.exp(s - m)
    p = p / (jnp.sum(p, axis=-1, keepdims=True) + jnp.exp(sink - m))
    return jnp.einsum('...hgqk,...khd->...qhgd', p.astype(v.dtype), v)


def _attend_prompt(q, k, v, sinks):
    b, s_len = q.shape[0], q.shape[1]
    nb = s_len // BLOCK
    qb = q.reshape(b, nb, BLOCK, N_KV_HEADS, GROUP, HEAD_DIM)
    kb = k.reshape(b, nb, BLOCK, N_KV_HEADS, HEAD_DIM)
    vb = v.reshape(b, nb, BLOCK, N_KV_HEADS, HEAD_DIM)

    def with_prev(t):
        prev = jnp.concatenate([jnp.zeros_like(t[:, :1]), t[:, :-1]], axis=1)
        return jnp.concatenate([prev, t], axis=2)

    kk, vv = with_prev(kb), with_prev(vb)
    i = jnp.arange(BLOCK)[:, None]
    j = jnp.arange(2 * BLOCK)[None, :]
    dist = BLOCK + i - j
    kpos = jnp.arange(nb)[:, None, None] * BLOCK - BLOCK + j[None]
    valid = (dist >= 0) & (dist <= WINDOW) & (kpos >= 0)
    o = _sink_attend(qb, kk, vv, dist.astype(jnp.float32), valid, sinks)
    return o.reshape(b, s_len, Q_WIDTH), k[:, -WINDOW:], v[:, -WINDOW:]


def _make_attend_sample(k_buf, v_buf):
    def attend(q, k, v, sinks):
        b, t = q.shape[0], q.shape[1]
        lb = k_buf.shape[1]
        kk = jnp.concatenate([k_buf.astype(k.dtype), k], axis=1)
        vv = jnp.concatenate([v_buf.astype(v.dtype), v], axis=1)
        i = jnp.arange(t)[:, None]
        j = jnp.arange(lb + t)[None, :]
        dist = lb + i - j
        valid = (dist >= 0) & (dist <= WINDOW)
        o = _sink_attend(q, kk, vv, dist.astype(jnp.float32), valid, sinks)
        return o.reshape(b, t, Q_WIDTH), kk[:, t:], vv[:, t:]
    return attend


def _layer(x, c, conv_buf, ffn_buf, attend, norm1_g, norm2_g, w_ada, b_ada, w_in, conv_w,
           w_conv_out, attn_sinks, w_attn_out, w_mix_out, w_up, ffn_conv_w, w_down):
    b, t = x.shape[0], x.shape[1]
    mod = jax.nn.silu(c) @ w_ada + b_ada
    sh1, sc1, g1, sh2, sc2, g2 = [m[:, None, :] for m in jnp.split(mod, 6, axis=-1)]

    h = _rmsnorm(x, norm1_g) * (1.0 + sc1) + sh1
    proj = h @ w_in
    cuts = np.cumsum([D_CONV, D_CONV, D_CONV, Q_WIDTH, KV_WIDTH, KV_WIDTH, D_MODEL]).tolist()
    b_gate, c_gate, xa, q, k, v, ga, gb = jnp.split(proj, cuts, axis=-1)
    u = c_gate * xa
    uc, new_conv = _causal_conv(u, conv_buf, conv_w)
    ya = (b_gate * uc) @ w_conv_out
    q = q.reshape(b, t, N_KV_HEADS, GROUP, HEAD_DIM)
    k = k.reshape(b, t, N_KV_HEADS, HEAD_DIM)
    v = v.reshape(b, t, N_KV_HEADS, HEAD_DIM)
    o, k_state, v_state = attend(q, k, v, attn_sinks.reshape(N_KV_HEADS, GROUP))
    yb = o @ w_attn_out
    mixed = jax.nn.sigmoid(ga) * ya + jax.nn.sigmoid(gb) * yb
    x = x + g1 * (mixed @ w_mix_out)

    h2 = _rmsnorm(x, norm2_g) * (1.0 + sc2) + sh2
    a, val = jnp.split(h2 @ w_up, 2, axis=-1)
    ac, new_ffn = _causal_conv(a, ffn_buf, ffn_conv_w)
    x = x + g2 * ((jax.nn.gelu(ac, approximate=False) * val) @ w_down)
    return x, new_conv, k_state, v_state, new_ffn


def setup_inputs(seed: int = 0) -> dict:
    key = jax.random.key(seed)
    ks = jax.random.split(key, 24)
    f32 = jnp.float32

    def nrm(k, shape, scale=1.0):
        return jax.random.normal(k, shape, f32) * scale

    buf_len = min(WINDOW, PAST_LEN)
    return {
        'x_prompt': nrm(ks[0], (BATCH, SEQ, D_MODEL)),
        'x_sample': nrm(ks[1], (DEC_BATCH, DEC_SEQ, D_MODEL)),
        'c_prompt': nrm(ks[2], (BATCH, D_MODEL)),
        'c_sample': nrm(ks[3], (DEC_BATCH, D_MODEL)),
        'state_conv': nrm(ks[4], (DEPTH, DEC_BATCH, CONV_WIDTH - 1, D_CONV)),
        'cache_k_win': nrm(ks[5], (DEPTH, DEC_BATCH, buf_len, N_KV_HEADS, HEAD_DIM)),
        'cache_v_win': nrm(ks[6], (DEPTH, DEC_BATCH, buf_len, N_KV_HEADS, HEAD_DIM)),
        'state_ffn_conv': nrm(ks[7], (DEPTH, DEC_BATCH, CONV_WIDTH - 1, D_FF)),
        'norm1_g': 1.0 + nrm(ks[8], (DEPTH, D_MODEL), 0.01),
        'norm2_g': 1.0 + nrm(ks[9], (DEPTH, D_MODEL), 0.01),
        'w_ada': nrm(ks[10], (DEPTH, D_MODEL, 6 * D_MODEL), 0.3 * D_MODEL ** -0.5),
        'b_ada': nrm(ks[11], (DEPTH, 6 * D_MODEL), 0.01),
        'w_in': nrm(ks[12], (DEPTH, D_MODEL, IN_WIDTH), D_MODEL ** -0.5),
        'conv_w': nrm(ks[13], (DEPTH, CONV_WIDTH, D_CONV), CONV_WIDTH ** -0.5),
        'w_conv_out': nrm(ks[14], (DEPTH, D_CONV, D_MODEL), D_CONV ** -0.5),
        'attn_sinks': nrm(ks[15], (DEPTH, N_HEADS)),
        'w_attn_out': nrm(ks[16], (DEPTH, Q_WIDTH, D_MODEL), Q_WIDTH ** -0.5),
        'w_mix_out': nrm(ks[17], (DEPTH, D_MODEL, D_MODEL), D_MODEL ** -0.5),
        'w_up': nrm(ks[18], (DEPTH, D_MODEL, 2 * D_FF), D_MODEL ** -0.5),
        'ffn_conv_w': nrm(ks[19], (DEPTH, CONV_WIDTH, D_FF), CONV_WIDTH ** -0.5),
        'w_down': nrm(ks[20], (DEPTH, D_FF, D_MODEL), D_FF ** -0.5),
        'final_g': 1.0 + nrm(ks[21], (D_MODEL,), 0.01),
    }


def reference(x_prompt, x_sample, c_prompt, c_sample, state_conv, cache_k_win, cache_v_win,
              state_ffn_conv, norm1_g, norm2_g, w_ada, b_ada, w_in, conv_w, w_conv_out,
              attn_sinks, w_attn_out, w_mix_out, w_up, ffn_conv_w, w_down, final_g):
    xp, xs = x_prompt, x_sample
    conv_p, k_p, v_p, ffn_p = [], [], [], []
    conv_s, k_s, v_s, ffn_s = [], [], [], []
    for layer in range(DEPTH):
        params = (norm1_g[layer], norm2_g[layer], w_ada[layer], b_ada[layer], w_in[layer],
                  conv_w[layer], w_conv_out[layer], attn_sinks[layer], w_attn_out[layer],
                  w_mix_out[layer], w_up[layer], ffn_conv_w[layer], w_down[layer])
        zero_conv = jnp.zeros((xp.shape[0], CONV_WIDTH - 1, D_CONV), xp.dtype)
        zero_ffn = jnp.zeros((xp.shape[0], CONV_WIDTH - 1, D_FF), xp.dtype)
        xp, cp_, kp_, vp_, fp_ = _layer(xp, c_prompt, zero_conv, zero_ffn, _attend_prompt, *params)
        attend_s = _make_attend_sample(cache_k_win[layer], cache_v_win[layer])
        xs, cs_, ks_, vs_, fs_ = _layer(xs, c_sample, state_conv[layer], state_ffn_conv[layer],
                                        attend_s, *params)
        conv_p.append(cp_); k_p.append(kp_); v_p.append(vp_); ffn_p.append(fp_)
        conv_s.append(cs_); k_s.append(ks_); v_s.append(vs_); ffn_s.append(fs_)
    y_prompt = _rmsnorm(xp, final_g)
    y_sample = _rmsnorm(xs, final_g)
    return (y_prompt, y_sample,
            jnp.stack(conv_p, axis=0), jnp.stack(k_p, axis=0), jnp.stack(v_p, axis=0),
            jnp.stack(ffn_p, axis=0),
            jnp.stack(conv_s, axis=0), jnp.stack(k_s, axis=0), jnp.stack(v_s, axis=0),
            jnp.stack(ffn_s, axis=0))
```

```cpp
#include <hip/hip_runtime.h>
#include <hip/hip_cooperative_groups.h>
#include <cstdio>
#include <cstdint>

#define GAS __attribute__((address_space(1)))
#define LAS __attribute__((address_space(3)))
typedef unsigned short bf16_t;
typedef short bf16x8 __attribute__((ext_vector_type(8)));
typedef short s16x4 __attribute__((ext_vector_type(4)));
typedef float f32x2 __attribute__((ext_vector_type(2)));
typedef float f32x4 __attribute__((ext_vector_type(4)));
typedef float f32x16 __attribute__((ext_vector_type(16)));
typedef unsigned u32x2 __attribute__((ext_vector_type(2)));
typedef unsigned u32x4 __attribute__((ext_vector_type(4)));

constexpr int M = 17408, MP = 16384, D = 1024, NIN = 6656, DFF = 2816, NUP = 5632, NBATCH = 136;
constexpr int SEQ = 2048, DSEQ = 8, NBP = 8, NBS = 128, WIN = 128, KVW = 256;
constexpr float RMS_EPS = 1e-6f, LOG2E = 1.4426950408889634f;
constexpr float QSCALE = 0.125f * LOG2E;
constexpr size_t O_Y = 0, O_CONV_P = 17825792, O_K_P = 17842176, O_V_P = 18104320, O_FFN_P = 18366464,
                 O_CONV_S = 18411520, O_K_S = 18673664, O_V_S = 22867968, O_FFN_S = 27062272, O_END = 27783168;
constexpr size_t MiB = 1u << 20;
constexpr size_t WS_CTL = 0, WS_WUP = 1 * MiB, WS_WDN = 12 * MiB, WS_MOD = 17 * MiB + 512 * 1024, WS_WIN = 21 * MiB, WS_WC = 34 * MiB, WS_WA = 36 * MiB, WS_WM = 38 * MiB,
                 WS_U = 40 * MiB, WS_BG = 74 * MiB, WS_Q = 108 * MiB, WS_SA = 142 * MiB, WS_SB = 176 * MiB, WS_K = 210 * MiB, WS_V = 218 * MiB + 512 * 1024,
                 WS_VAL = 148 * MiB + 512 * 1024, WS_SIDEL = 242 * MiB + 512 * 1024, WS_SIDEF = 245 * MiB, WS_SLOT3 = 248 * MiB, WS_SLOT5 = 250 * MiB, WS_END = 256 * MiB;
static_assert(WS_V + (size_t)M * KVW * 2 <= WS_END && WS_VAL + (size_t)M * DFF * 2 <= WS_SIDEL && WS_SLOT5 + (size_t)M * 16 * 4 <= WS_END && WS_SIDEF + (size_t)68 * 4 * DFF * 4 <= WS_SLOT3, "ws map");
static_assert(WS_MOD + (size_t)NBATCH * 6 * D * 4 <= WS_WIN && WS_WDN + (size_t)D * DFF * 2 <= WS_MOD && WS_WUP + (size_t)NUP * D * 2 <= WS_WDN && WS_WIN + (size_t)NIN * D * 2 <= WS_WC, "ws map 2");
constexpr int CW_BAR = 4096, CW_MODCNT = 1024, CW_CNT3 = 8192, CW_CNT5 = 16384, CTL_BYTES = 131072;

constexpr int NWAVES = 8;
constexpr int LDS_BYTES = 147456;
constexpr int MISC_OFF = LDS_BYTES - 128;

struct KP { const float* in[22]; float* out; unsigned char* ws; };
enum { I_XP = 0, I_XS, I_CP, I_CS, I_SCONV, I_CK, I_CV, I_SFFN, I_N1G, I_N2G, I_WADA, I_BADA, I_WIN, I_CONVW, I_WCO, I_SINK, I_WAO, I_WMIX, I_WUP, I_FCW, I_WDN, I_FING };

__device__ __forceinline__ unsigned f2bf(float f) { unsigned u = __builtin_bit_cast(unsigned, f); return (u + 0x7fffu + ((u >> 16) & 1u)) >> 16; }
__device__ __forceinline__ unsigned pk2(float lo, float hi) { return f2bf(lo) | (f2bf(hi) << 16); }
#define NT_LD(p) __builtin_nontemporal_load(p)
#define NT_ST(v, p) __builtin_nontemporal_store((v), (p))
typedef __bf16 bf16x2_t __attribute__((ext_vector_type(2)));
__device__ __forceinline__ unsigned cvtpk_s(float lo, float hi) { f32x2 v = {lo, hi}; bf16x2_t b = __builtin_convertvector(v, bf16x2_t); return __builtin_bit_cast(unsigned, b); }
__device__ __forceinline__ float bflo(unsigned w) { return __builtin_bit_cast(float, w << 16); }
__device__ __forceinline__ float bfhi(unsigned w) { return __builtin_bit_cast(float, w & 0xffff0000u); }
__device__ __forceinline__ float wave_sum(float v) {
#pragma unroll
    for (int o = 1; o < 64; o <<= 1) v += __shfl_xor(v, o);
    return v;
}
__device__ __forceinline__ float sigmoidf_(float x) { return __builtin_amdgcn_rcpf(1.f + __builtin_amdgcn_exp2f(-x * LOG2E)); }
__device__ __forceinline__ f32x2 gelu_pk(f32x2 v) {
    const f32x2 av = __builtin_elementwise_abs(v), d = av * 0.2316418882f + 1.0f;
    f32x2 t; t.x = __builtin_amdgcn_rcpf(d.x); t.y = __builtin_amdgcn_rcpf(d.y);
    f32x2 q = t * 0.5307027145f + (-0.7265760135f); q = q * t + 0.7107068705f; q = q * t + (-0.142248368f); q = q * t + 0.127414796f; q = q * t;
    const f32x2 s = (v * v) * (-0.72134752044f);
    f32x2 e; e.x = __builtin_amdgcn_exp2f(s.x); e.y = __builtin_amdgcn_exp2f(s.y);
    const f32x2 m = v * (q * e), r = v - m;
    f32x2 o; o.x = v.x < 0.f ? m.x : r.x; o.y = v.y < 0.f ? m.y : r.y; return o;
}
__device__ __forceinline__ int row_batch(int row) { return row < MP ? (row >> 11) : NBP + ((row - MP) >> 3); }

#define XB_TMO      128
#define XB_XCNT(j)  (256  + 64 * (j))
#define XB_XSUB(j)  (1280 + 64 * (j))
#define XB_XGEN(j)  (2304 + 64 * (j))
#define XB_TOP      3328
#define XB_TOPGEN   3392
#define XCD_BAR_WORDS 3456
#define XB_SPIN_CAP (1u << 18)
__device__ __forceinline__ unsigned xb_ld(unsigned* p)              { return __hip_atomic_load(p, __ATOMIC_RELAXED, __HIP_MEMORY_SCOPE_AGENT); }
__device__ __forceinline__ unsigned xb_add(unsigned* p, unsigned v) { return __hip_atomic_fetch_add(p, v, __ATOMIC_RELAXED, __HIP_MEMORY_SCOPE_AGENT); }
__device__ __forceinline__ unsigned xb_xcc_id() { return (unsigned)__builtin_amdgcn_s_getreg((3 << 11) | 20) & 0xFu; }
#define XB_SPIN(cond, bar) do { unsigned _sp = 0; while (cond) { __builtin_amdgcn_s_sleep(1); \
    if ((++_sp & 255u) == 0u) { if (xb_ld(&(bar)[XB_TMO])) break; if (_sp > XB_SPIN_CAP) { atomicAdd(&(bar)[XB_TMO], 1u); break; } } } } while (0)
struct XcdBarrier { unsigned* bar; unsigned x; volatile LAS unsigned* st; };
__device__ __forceinline__ XcdBarrier xcd_barrier_post(unsigned* bar, volatile LAS unsigned* st) {
    XcdBarrier b; b.bar = bar; b.x = xb_xcc_id(); b.st = st;
    if (threadIdx.x == 0) (void)xb_add(&bar[XB_XCNT(b.x)], 1u);
    return b;
}
__device__ __forceinline__ void xcd_barrier_complete(unsigned* bar, unsigned x, unsigned& nloc, unsigned& nx) {
    const unsigned G = gridDim.x * gridDim.y * gridDim.z;
    unsigned sum, cnt, mine, sp = 0u;
    for (;;) {
        sum = 0u; cnt = 0u; mine = 0u;
#pragma unroll
        for (unsigned j = 0; j < 16; ++j) { const unsigned c = xb_ld(&bar[XB_XCNT(j)]); sum += c; cnt += (c > 0u) ? 1u : 0u; mine = (j == x) ? c : mine; }
        if (sum == G) break;
        __builtin_amdgcn_s_sleep(1);
        if ((++sp & 255u) == 0u) { if (xb_ld(&bar[XB_TMO])) break; if (sp > XB_SPIN_CAP) { atomicAdd(&bar[XB_TMO], 1u); break; } }
    }
    nloc = mine > 0u ? mine : 1u; nx = cnt > 0u ? cnt : 1u;
}
__device__ __forceinline__ void xcd_barrier(const XcdBarrier& b) {
    asm volatile("s_waitcnt vmcnt(0)" ::: "memory");
    __syncthreads();
    if (threadIdx.x == 0) {
        unsigned* bar = b.bar;
        __builtin_amdgcn_s_waitcnt(0);
        unsigned nloc = b.st[0], nx = b.st[1];
        if (nloc == 0u) { xcd_barrier_complete(bar, b.x, nloc, nx); b.st[0] = nloc; b.st[1] = nx; }
        const unsigned old = xb_add(&bar[XB_XSUB(b.x)], 1u);
        const unsigned gen = old / nloc;
        if (old + 1u == (gen + 1u) * nloc) {
            __builtin_amdgcn_fence(__ATOMIC_RELEASE, "agent");
            asm volatile("s_waitcnt vmcnt(0)" ::: "memory");
            const unsigned og = xb_add(&bar[XB_TOP], 1u);
            const unsigned tg = og / nx;
            if (og + 1u == (tg + 1u) * nx) xb_add(&bar[XB_TOPGEN], 1u);
            else XB_SPIN(xb_ld(&bar[XB_TOPGEN]) == tg, bar);
            __builtin_amdgcn_fence(__ATOMIC_ACQUIRE, "agent");
            xb_add(&bar[XB_XGEN(b.x)], 1u);
            asm volatile("s_waitcnt vmcnt(0)" ::: "memory");
        } else {
            XB_SPIN(xb_ld(&bar[XB_XGEN(b.x)]) == gen, bar);
            __builtin_amdgcn_fence(__ATOMIC_ACQUIRE, "agent");
            asm volatile("s_waitcnt vmcnt(0)" ::: "memory");
        }
    }
    __syncthreads();
}

namespace pg8 {
constexpr int BM = 256, BK = 64, HALF = 128, HTB = HALF * BK * 2, STAGE_BYTES = 8 * HTB, NXCD = 8, WGM = 4;
__host__ __device__ __forceinline__ int lds_byte(int r, int c) { const int st = (r >> 4) * 2 + (c >> 5), rr = r & 15, cc = c & 31, ob = rr * 64 + cc * 2; return st * 1024 + (ob ^ (((ob >> 9) & 1) << 5)); }
__host__ __device__ __forceinline__ void stage_rc(int b, int& R, int& C) { const int st = b / 1024, sb = b % 1024, swz = sb ^ (((sb >> 9) & 1) << 5); R = (st >> 1) * 16 + swz / 64; C = (st & 1) * 32 + (swz % 64) / 2; }
__host__ __device__ __forceinline__ int perm32(int rho) { const int n = rho >> 4, i = rho & 15; return 8 * (i >> 2) + 4 * n + (i & 3); }

struct Unit { int pm, pn, kind; __amdgpu_buffer_rsrc_t ra, rb; unsigned a, b, x; };

__device__ __forceinline__ void tile_of(int L, int nM, int nN, int& pm, int& pn) {
    const int nwg = nM * nN; int wgid = L;
    { const int q = nwg / NXCD, r = nwg % NXCD, xcd = wgid % NXCD, off = wgid / NXCD; wgid = (xcd < r ? xcd * (q + 1) : r * (q + 1) + (xcd - r) * q) + off; }
    const int nig = WGM * nN, gid = wgid / nig, fm = gid * WGM, gsz = (nM - fm) < WGM ? (nM - fm) : WGM;
    pm = fm + ((wgid % nig) % gsz); pn = (wgid % nig) / gsz;
}

constexpr int XS_OFF = 131072;
template <class Epi, class Sched, bool XS>
__device__ __forceinline__ void gemm_phase(LAS unsigned char* lds, const int K, const Sched& S, const Epi& E) {
    int tid = threadIdx.x; asm volatile("" : "+v"(tid));
    const int wid = __builtin_amdgcn_readfirstlane(tid >> 6), lane = tid & 63, wr = wid >> 2, wc = wid & 3, fr = lane & 15, fq = lane >> 4;
    const int nt = K / BK;
    unsigned voffA, voffB;
    { int R, C; stage_rc(tid * 16, R, C); const int Rb = (R & ~31) + perm32(R & 31); voffA = (unsigned)(R * K + C) * 2u; voffB = (unsigned)(Rb * K + C) * 2u; }
    const unsigned rstep = (unsigned)(64 * K * 2);
#define PG8_VOFFX() ({ int l_ = (int)(threadIdx.x & 63); asm volatile("" : "+v"(l_)); (unsigned)((2 * wid + (l_ >> 5)) * K) * 2u + (unsigned)(l_ & 31) * 4u; })
#define PG8_XOFF() ({ int l_ = (int)(threadIdx.x & 63); asm volatile("" : "+v"(l_)); XS_OFF + (l_ & 15) * 128 + (l_ >> 4) * 16; })
    const unsigned kstep = (unsigned)(BK * 2);
    const unsigned hstep = (unsigned)(HALF * K * 2);
    const unsigned ldsw = (unsigned)wid * 1024u;
    const int aoff = lds_byte(wr * 64 + fr, fq * 8), boff = lds_byte(wc * 32 + fr, fq * 8);
#define PG8_SA(b, h) (((b) * 2 + (h)) * HTB)
#define PG8_SB(b, h) ((4 + (b) * 2 + (h)) * HTB)
#define PG8_STAGE(bufoff, rsrc, soff, voff) do { _Pragma("unroll") for (int _i = 0; _i < 2; ++_i) \
        __builtin_amdgcn_raw_ptr_buffer_load_lds((rsrc), (LAS void*)(lds + (bufoff) + ldsw + _i * 8192), 16, (voff), (soff) + _i * rstep, 0, 0); } while (0)
#define PG8_STAGEX(b, rsrc, soff) do { if constexpr (XS) __builtin_amdgcn_raw_ptr_buffer_load_lds((rsrc), (LAS void*)(lds + XS_OFF + (b) * 2048 + wid * 256), 4, PG8_VOFFX(), (soff), 0, 0); } while (0)
#define PG8_LDA(dst, b, h) do { _Pragma("unroll") for (int m = 0; m < 4; ++m) _Pragma("unroll") for (int k = 0; k < 2; ++k) dst[m][k] = *(const LAS bf16x8*)(lds + PG8_SA(b, h) + aoff + m * 2048 + k * 1024); } while (0)
#define PG8_LDB(dst, b, h) do { _Pragma("unroll") for (int n = 0; n < 2; ++n) _Pragma("unroll") for (int k = 0; k < 2; ++k) dst[n][k] = *(const LAS bf16x8*)(lds + PG8_SB(b, h) + boff + n * 2048 + k * 1024); } while (0)
#define PG8_LDX(b) do { if constexpr (XS) { const int xo_ = PG8_XOFF(); Xf[0] = *(const LAS bf16x8*)(lds + xo_ + (b) * 2048); Xf[1] = *(const LAS bf16x8*)(lds + xo_ + (b) * 2048 + 64); } } while (0)
#define PG8_MMA(ai, bj, At, Bt) do { __builtin_amdgcn_s_setprio(1); _Pragma("unroll") for (int m = 0; m < 4; ++m) _Pragma("unroll") for (int n = 0; n < 2; ++n) _Pragma("unroll") for (int k = 0; k < 2; ++k) \
        acc[ai][bj][m][n] = __builtin_amdgcn_mfma_f32_16x16x32_bf16(Bt[n][k], At[m][k], acc[ai][bj][m][n], 0, 0, 0); __builtin_amdgcn_s_setprio(0); } while (0)
#define PG8_MMAX() do { if constexpr (XS) { if (wr == 0) { _Pragma("unroll") for (int n = 0; n < 2; ++n) _Pragma("unroll") for (int k = 0; k < 2; ++k) ax[n] = __builtin_amdgcn_mfma_f32_16x16x32_bf16(B0[n][k], Xf[k], ax[n], 0, 0, 0); } \
        else { _Pragma("unroll") for (int n = 0; n < 2; ++n) _Pragma("unroll") for (int k = 0; k < 2; ++k) ax[n] = __builtin_amdgcn_mfma_f32_16x16x32_bf16(B1[n][k], Xf[k], ax[n], 0, 0, 0); } } } while (0)
#define PG8_WAIT_V(n) asm volatile("s_waitcnt vmcnt(" #n ")" ::: "memory")
#define PG8_WAIT_VL() do { if constexpr (XS) PG8_WAIT_V(9); else PG8_WAIT_V(8); } while (0)
#define PG8_WAIT_L(n) asm volatile("s_waitcnt lgkmcnt(" #n ")" ::: "memory")
#define PG8_BAR __builtin_amdgcn_s_barrier()
#define PG8_SCHED __builtin_amdgcn_sched_barrier(0)
    Unit cur, nxt; int ui = 0;
    if (!S.next(0, cur)) return;
    f32x4 acc[2][2][4][2];
#pragma unroll
    for (int a = 0; a < 2; ++a)
#pragma unroll
        for (int b = 0; b < 2; ++b)
#pragma unroll
            for (int m = 0; m < 4; ++m)
#pragma unroll
                for (int n = 0; n < 2; ++n) acc[a][b][m][n] = (f32x4){0.f, 0.f, 0.f, 0.f};
    f32x4 ax[2] = {{0.f, 0.f, 0.f, 0.f}, {0.f, 0.f, 0.f, 0.f}};
    bf16x8 At[4][2], B0[2][2], B1[2][2], Xf[2];
    unsigned cA = cur.a, cB = cur.b, cX = cur.x; __amdgpu_buffer_rsrc_t rA = cur.ra, rB = cur.rb;
    PG8_STAGE(PG8_SB(0, 0), rB, cB, voffB); PG8_STAGE(PG8_SB(0, 1), rB, cB + hstep, voffB); PG8_STAGE(PG8_SA(0, 0), rA, cA, voffA); PG8_STAGEX(0, rA, cX); PG8_STAGE(PG8_SA(0, 1), rA, cA + hstep, voffA);
    if (wr == 1) PG8_BAR;
    PG8_WAIT_V(2); PG8_BAR;
    PG8_STAGEX(1, rA, cX + kstep); PG8_STAGE(PG8_SB(1, 0), rB, cB + kstep, voffB); PG8_STAGE(PG8_SA(1, 0), rA, cA + kstep, voffA); PG8_STAGE(PG8_SB(1, 1), rB, cB + hstep + kstep, voffB);
    if constexpr (XS) PG8_WAIT_V(7); else PG8_WAIT_V(6);
    PG8_BAR;
    for (;;) {
        const bool has_next = S.next(ui + 1, nxt);
        const unsigned nA = has_next ? nxt.a : cA, nB = has_next ? nxt.b : cB, nX = has_next ? nxt.x : cX;
        const __amdgpu_buffer_rsrc_t nrA = has_next ? nxt.ra : rA, nrB = has_next ? nxt.rb : rB;
        for (int t = 0; t < nt; t += 2) {
            const bool last = (t == nt - 2);
            const unsigned a1 = cA + (unsigned)(t + 1) * kstep;
            const unsigned a2 = last ? nA : cA + (unsigned)(t + 2) * kstep, b2 = last ? nB : cB + (unsigned)(t + 2) * kstep, x2 = last ? nX : cX + (unsigned)(t + 2) * kstep;
            const unsigned a3 = a2 + kstep, b3 = b2 + kstep, x3 = x2 + kstep;
            const __amdgpu_buffer_rsrc_t r2A = last ? nrA : rA, r2B = last ? nrB : rB;
            PG8_LDB(B0, 0, 0); PG8_LDB(B1, 0, 1); PG8_LDX(0); PG8_SCHED; PG8_LDA(At, 0, 0); PG8_STAGE(PG8_SA(1, 1), rA, a1 + hstep, voffA);
            PG8_WAIT_VL(); PG8_WAIT_L(0); PG8_BAR; PG8_MMA(0, 0, At, B0); PG8_MMA(0, 1, At, B1); PG8_MMAX(); PG8_BAR; PG8_SCHED;
            PG8_LDA(At, 0, 1); PG8_STAGE(PG8_SB(0, 0), r2B, b2, voffB); PG8_STAGE(PG8_SB(0, 1), r2B, b2 + hstep, voffB); PG8_STAGE(PG8_SA(0, 0), r2A, a2, voffA); PG8_STAGEX(0, r2A, x2);
            PG8_WAIT_VL(); PG8_WAIT_L(0); PG8_BAR; PG8_MMA(1, 0, At, B0); PG8_MMA(1, 1, At, B1); PG8_BAR; PG8_SCHED;
            PG8_LDB(B0, 1, 0); PG8_LDB(B1, 1, 1); PG8_LDX(1); PG8_SCHED; PG8_LDA(At, 1, 0); PG8_STAGE(PG8_SA(0, 1), r2A, a2 + hstep, voffA);
            PG8_WAIT_VL(); PG8_WAIT_L(0); PG8_BAR; PG8_MMA(0, 0, At, B0); PG8_MMA(0, 1, At, B1); PG8_MMAX(); PG8_BAR; PG8_SCHED;
            PG8_LDA(At, 1, 1); PG8_STAGE(PG8_SB(1, 0), r2B, b3, voffB); PG8_STAGE(PG8_SB(1, 1), r2B, b3 + hstep, voffB); PG8_STAGE(PG8_SA(1, 0), r2A, a3, voffA); PG8_STAGEX(1, r2A, x3);
            PG8_WAIT_VL(); PG8_WAIT_L(0); PG8_BAR; PG8_MMA(1, 0, At, B0); PG8_MMA(1, 1, At, B1); PG8_BAR; PG8_SCHED;
        }
        if (wr == 0) PG8_BAR;
        const bool keep = E(acc, ax, cur, wr, wc, fr, fq);
        if (!has_next) break;
        if (!keep) {
#pragma unroll
            for (int a = 0; a < 2; ++a)
#pragma unroll
                for (int b = 0; b < 2; ++b)
#pragma unroll
                    for (int m = 0; m < 4; ++m)
#pragma unroll
                        for (int n = 0; n < 2; ++n) acc[a][b][m][n] = (f32x4){0.f, 0.f, 0.f, 0.f};
            ax[0] = (f32x4){0.f, 0.f, 0.f, 0.f}; ax[1] = ax[0];
        }
        cur = nxt; cA = nA; cB = nB; cX = nX; rA = nrA; rB = nrB; ++ui;
        if (wr == 1) PG8_BAR;
    }
    PG8_WAIT_V(0);
    PG8_BAR;
#undef PG8_SA
#undef PG8_SB
#undef PG8_STAGE
#undef PG8_STAGEX
#undef PG8_VOFFX
#undef PG8_XOFF
#undef PG8_LDA
#undef PG8_LDB
#undef PG8_LDX
#undef PG8_MMA
#undef PG8_MMAX
#undef PG8_WAIT_V
#undef PG8_WAIT_VL
#undef PG8_WAIT_L
#undef PG8_BAR
#undef PG8_SCHED
}
}
using pg8::Unit;
typedef f32x4 Acc[2][2][4][2];

__device__ __forceinline__ void unpack8(const u32x4 w, f32x4& a, f32x4& b) { a = (f32x4){bflo(w.x), bfhi(w.x), bflo(w.y), bfhi(w.y)}; b = (f32x4){bflo(w.z), bfhi(w.z), bflo(w.w), bfhi(w.w)}; }
#define MK_RSRC(p) __builtin_amdgcn_make_buffer_rsrc((void*)(p), 0, 0x7fffffff, 0x00020000)
struct SchedPlain {
    const char* A; const char* Bt; int nM, nN, G, c; size_t tstep;
    __device__ __forceinline__ bool next(int i, Unit& u) const {
        const long L = (long)i * G + c; if (L >= (long)nM * nN) return false;
        pg8::tile_of((int)L, nM, nN, u.pm, u.pn); u.kind = 0; u.ra = MK_RSRC(A); u.rb = MK_RSRC(Bt);
        u.a = (unsigned)((size_t)u.pm * tstep); u.b = (unsigned)((size_t)u.pn * tstep); u.x = (unsigned)((size_t)(MP + 16 * u.pm) * (tstep / 256)); return true;
    }
};
struct SchedPair {
    const char* A0; const char* B0; const char* A1; const char* B1; int nM, nN, G, c; size_t tstep;
    __device__ __forceinline__ bool next(int i, Unit& u) const {
        const long L = (long)(i >> 1) * G + c; if (L >= (long)nM * nN) return false;
        pg8::tile_of((int)L, nM, nN, u.pm, u.pn); u.kind = i & 1; u.ra = MK_RSRC((i & 1) ? A1 : A0); u.rb = MK_RSRC((i & 1) ? B1 : B0);
        u.a = (unsigned)((size_t)u.pm * tstep); u.b = (unsigned)((size_t)u.pn * tstep); u.x = (unsigned)((size_t)(MP + 16 * u.pm) * (tstep / 256)); return true;
    }
};

#define EPI_ROWS(ai, m) (u.pm * 256 + (ai) * 128 + wr * 64 + (m) * 16 + fr)
__device__ __forceinline__ u32x4 pack8(const f32x4 v0, const f32x4 v1) { u32x4 w; w.x = cvtpk_s(v0[0], v0[1]); w.y = cvtpk_s(v0[2], v0[3]); w.z = cvtpk_s(v1[0], v1[1]); w.w = cvtpk_s(v1[2], v1[3]); return w; }

struct EpiG1 {
    bf16_t *U, *BG, *Q, *KB, *VB, *SA, *SB; float* out;
    __device__ __forceinline__ bool operator()(Acc& acc, f32x4 (&ax)[2], const Unit& u, int wr, int wc, int fr, int fq) const {
        const int pn = u.pn, cw = wc * 32 + 8 * fq; const bool samp = u.pm >= 64;
        if (pn < 8) {
#pragma unroll
            for (int ai = 0; ai < 2; ++ai)
#pragma unroll
                for (int m = 0; m < 4; ++m) { const int row = EPI_ROWS(ai, m); const int col = pn * 128 + cw;
                    const f32x4 v0 = acc[ai][0][m][0] * acc[ai][1][m][0], v1 = acc[ai][0][m][1] * acc[ai][1][m][1];
                    *(u32x4*)(U + (size_t)row * D + col) = pack8(v0, v1);
                    float* so = nullptr;
                    if (!samp) { const int t = row & 2047; if (t >= 2046) so = out + O_CONV_P + (size_t)((row >> 11) * 2 + (t - 2046)) * D + col; }
                    else { const int rs = row - MP, t = rs & 7; if (t >= 6) so = out + O_CONV_S + (size_t)((rs >> 3) * 2 + (t - 6)) * D + col; }
                    if (so) { NT_ST(v0, (f32x4*)so); NT_ST(v1, (f32x4*)(so + 4)); } }
        } else if (pn < 16) {
            bf16_t* dst = pn < 12 ? BG : Q; const float sc = pn < 12 ? 1.f : QSCALE; const int c0 = ((pn - 8) & 3) * 256 + cw;
#pragma unroll
            for (int ai = 0; ai < 2; ++ai)
#pragma unroll
                for (int m = 0; m < 4; ++m) { const int row = EPI_ROWS(ai, m);
#pragma unroll
                    for (int bj = 0; bj < 2; ++bj) *(u32x4*)(dst + (size_t)row * D + c0 + bj * 128) = pack8(acc[ai][bj][m][0] * sc, acc[ai][bj][m][1] * sc); }
        } else if (pn < 18) {
            bf16_t* dst = pn == 16 ? KB : VB; float* wo = out + (pn == 16 ? (samp ? O_K_S : O_K_P) : (samp ? O_V_S : O_V_P));
#pragma unroll
            for (int ai = 0; ai < 2; ++ai)
#pragma unroll
                for (int m = 0; m < 4; ++m) { const int row = EPI_ROWS(ai, m);
                    long wrow = -1;
                    if (!samp) { const int t = row & 2047; if (t >= SEQ - WIN) wrow = (long)(row >> 11) * WIN + (t - (SEQ - WIN)); }
                    else { const int rs = row - MP; wrow = (long)(rs >> 3) * WIN + (WIN - DSEQ) + (rs & 7); }
#pragma unroll
                    for (int bj = 0; bj < 2; ++bj) { const int col = cw + bj * 128;
                        *(u32x4*)(dst + (size_t)row * KVW + col) = pack8(acc[ai][bj][m][0], acc[ai][bj][m][1]);
                        if (wrow >= 0) { float* o = wo + (size_t)wrow * KVW + col; NT_ST(acc[ai][bj][m][0], (f32x4*)o); NT_ST(acc[ai][bj][m][1], (f32x4*)(o + 4)); } } }
        } else {
            const int col = (pn - 18) * 128 + cw;
#pragma unroll
            for (int ai = 0; ai < 2; ++ai)
#pragma unroll
                for (int m = 0; m < 4; ++m) { const int row = EPI_ROWS(ai, m);
                    { f32x4 a0, a1, r0, r1;
#pragma unroll
                      for (int j = 0; j < 4; ++j) { const float ea0 = 1.f + __builtin_amdgcn_exp2f(-acc[ai][0][m][0][j] * LOG2E), ea1 = 1.f + __builtin_amdgcn_exp2f(-acc[ai][0][m][1][j] * LOG2E);
                          a0[j] = __builtin_amdgcn_rcpf(ea0); a1[j] = __builtin_amdgcn_rcpf(ea1);
                          r0[j] = ea0 * sigmoidf_(acc[ai][1][m][0][j]); r1[j] = ea1 * sigmoidf_(acc[ai][1][m][1][j]); }
                      *(u32x4*)(SA + (size_t)row * D + col) = pack8(a0, a1); *(u32x4*)(SB + (size_t)row * D + col) = pack8(r0, r1); } }
        }
        return false;
    }
};
struct EpiG2 {
    bf16_t *SA; const bf16_t *SB; bf16_t* MIX;
    __device__ __forceinline__ void elem(int row, int col, f32x4& v0, f32x4& v1, int step) const {
        const size_t off = (size_t)row * D + col;
        const u32x4 a = *(const u32x4*)((step == 0 ? SB : SA) + off);
        const f32x4 s0 = {bflo(a.x), bfhi(a.x), bflo(a.y), bfhi(a.y)}, s1 = {bflo(a.z), bfhi(a.z), bflo(a.w), bfhi(a.w)};
        if (step == 0) { v0 = v0 * s0; v1 = v1 * s1; }
        else *(u32x4*)(MIX + off) = pack8(v0 * s0, v1 * s1);
    }
    __device__ __forceinline__ bool operator()(Acc& acc, f32x4 (&ax)[2], const Unit& u, int wr, int wc, int fr, int fq) const {
        const int cw = u.pn * 256 + wc * 32 + 8 * fq;
#pragma unroll
        for (int ai = 0; ai < 2; ++ai)
#pragma unroll
            for (int m = 0; m < 4; ++m)
#pragma unroll
                for (int bj = 0; bj < 2; ++bj) elem(EPI_ROWS(ai, m), cw + bj * 128, acc[ai][bj][m][0], acc[ai][bj][m][1], u.kind);
        elem(MP + 16 * u.pm + fr, cw + wr * 128, ax[0], ax[1], u.kind);
        return u.kind == 0;
    }
};
constexpr int TAB_OFF = 136192;
struct RowStat { float* slots; unsigned* cnt; unsigned* tmo; LAS float* tab; };
__device__ __forceinline__ void rowstat_wait(const RowStat& st, int cidx, unsigned want) {
    unsigned* c = st.cnt + 64 * cidx; unsigned sp = 0;
    while ((unsigned)__builtin_amdgcn_readfirstlane(xb_ld(c)) < want) { __builtin_amdgcn_s_sleep(2);
        if ((++sp & 255u) == 0u) { if (xb_ld(st.tmo)) break; if (sp > XB_SPIN_CAP) { if ((threadIdx.x & 63) == 0) atomicAdd(st.tmo, 1u); break; } } }
    __builtin_amdgcn_fence(__ATOMIC_ACQUIRE, "agent");
}
#define RS_BAR() do { asm volatile("s_waitcnt vmcnt(0) lgkmcnt(0)" ::: "memory"); __builtin_amdgcn_s_barrier(); asm volatile("" ::: "memory"); } while (0)
__device__ __forceinline__ void rowstat_big(const RowStat& st, const Acc& v, const f32x4 (&ax)[2], const Unit& u, int wr, int wc, int fr, int fq) {
    const int lane = threadIdx.x & 63, wid = __builtin_amdgcn_readfirstlane(threadIdx.x >> 6);
    LAS float* P = st.tab; LAS float* S = st.tab + 1024; LAS float* PX = st.tab + 1312;
#pragma unroll
    for (int ai = 0; ai < 2; ++ai)
#pragma unroll
        for (int m = 0; m < 4; ++m) { float q = 0.f;
#pragma unroll
            for (int bj = 0; bj < 2; ++bj)
#pragma unroll
                for (int n = 0; n < 2; ++n) { const f32x4 x = v[ai][bj][m][n]; q += (x[0] * x[0] + x[1] * x[1]) + (x[2] * x[2] + x[3] * x[3]); }
            q += __shfl_xor(q, 16); q += __shfl_xor(q, 32);
            if (fq == 0) P[(ai * 128 + wr * 64 + m * 16 + fr) * 4 + wc] = q; }
    { float q = ((ax[0][0] * ax[0][0] + ax[0][1] * ax[0][1]) + (ax[0][2] * ax[0][2] + ax[0][3] * ax[0][3])) + ((ax[1][0] * ax[1][0] + ax[1][1] * ax[1][1]) + (ax[1][2] * ax[1][2] + ax[1][3] * ax[1][3]));
      q += __shfl_xor(q, 16); q += __shfl_xor(q, 32);
      if (fq == 0) PX[fr * 8 + wr * 4 + wc] = q; }
    RS_BAR();
    const int row = wid * 32 + (lane & 31);
    float* myslots = st.slots + (size_t)(u.pm * 4 + u.pn) * 272;
    if (lane < 32) { const f32x4 q = *(const LAS f32x4*)(P + row * 4);
        __hip_atomic_store(myslots + row, (q[0] + q[1]) + (q[2] + q[3]), __ATOMIC_RELAXED, __HIP_MEMORY_SCOPE_AGENT); }
    if (wid == 4 && lane < 16) { const f32x4 q0 = *(const LAS f32x4*)(PX + lane * 8), q1 = *(const LAS f32x4*)(PX + lane * 8 + 4);
        __hip_atomic_store(myslots + 256 + lane, ((q0[0] + q0[1]) + (q0[2] + q0[3])) + ((q1[0] + q1[1]) + (q1[2] + q1[3])), __ATOMIC_RELAXED, __HIP_MEMORY_SCOPE_AGENT); }
    asm volatile("s_waitcnt vmcnt(0)" ::: "memory");
    if (lane == 0) (void)xb_add(st.cnt + 64 * u.pm, 1u);
    if (wid == 0) rowstat_wait(st, u.pm, 32u);
    RS_BAR();
    const float* psl = st.slots + (size_t)(u.pm * 4) * 272;
    if (lane < 32) { float t = 0.f;
#pragma unroll
        for (int k = 0; k < 4; ++k) t += __hip_atomic_load(psl + k * 272 + row, __ATOMIC_RELAXED, __HIP_MEMORY_SCOPE_AGENT);
        S[row] = 1.0f / sqrtf(t * (1.f / D) + RMS_EPS); }
    if (wid == 4 && lane < 16) { float t = 0.f;
#pragma unroll
        for (int k = 0; k < 4; ++k) t += __hip_atomic_load(psl + k * 272 + 256 + lane, __ATOMIC_RELAXED, __HIP_MEMORY_SCOPE_AGENT);
        S[256 + lane] = 1.0f / sqrtf(t * (1.f / D) + RMS_EPS); }
    RS_BAR();
}
struct EpiG3N {
    const float* xp; const float* xs; bf16_t* X1; bf16_t* H2; const float* mod; const float* n2g; RowStat st;
    __device__ __forceinline__ void h2_store(int row, int col, const float* md, float rstd, const f32x4& v0, const f32x4& v1) const {
        const f32x4 g0 = *(const f32x4*)(n2g + col), g1 = *(const f32x4*)(n2g + col + 4), c0 = *(const f32x4*)(md + 4 * D + col), c1 = *(const f32x4*)(md + 4 * D + col + 4),
                    h0 = *(const f32x4*)(md + 3 * D + col), h1 = *(const f32x4*)(md + 3 * D + col + 4);
        *(u32x4*)(H2 + (size_t)row * D + col) = pack8(v0 * rstd * g0 * (c0 + 1.0f) + h0, v1 * rstd * g1 * (c1 + 1.0f) + h1);
    }
    __device__ __forceinline__ bool operator()(Acc& acc, f32x4 (&ax)[2], const Unit& u, int wr, int wc, int fr, int fq) const {
        const int cw = u.pn * 256 + wc * 32 + 8 * fq; const float* md = mod + (size_t)(u.pm >> 3) * (6 * D);
        {
            f32x4 gg[2][2];
#pragma unroll
            for (int bj = 0; bj < 2; ++bj) { gg[bj][0] = *(const f32x4*)(md + 2 * D + cw + bj * 128); gg[bj][1] = *(const f32x4*)(md + 2 * D + cw + bj * 128 + 4); }
#pragma unroll
            for (int ai = 0; ai < 2; ++ai)
#pragma unroll
                for (int m = 0; m < 4; ++m) { const int row = EPI_ROWS(ai, m);
#pragma unroll
                    for (int bj = 0; bj < 2; ++bj) { const float* src = xp + (size_t)row * D + cw + bj * 128;
                        const f32x4 x0 = *(const f32x4*)src, x1 = *(const f32x4*)(src + 4);
                        acc[ai][bj][m][0] = x0 + gg[bj][0] * acc[ai][bj][m][0]; acc[ai][bj][m][1] = x1 + gg[bj][1] * acc[ai][bj][m][1]; }
                    asm volatile("" : "+v"(acc[ai][0][m][0]), "+v"(acc[ai][0][m][1]), "+v"(acc[ai][1][m][0]), "+v"(acc[ai][1][m][1]));
                    if (m & 1) asm volatile("" ::: "memory"); }
        }
        const int xrow = MP + 16 * u.pm + fr, xcol = cw + wr * 128; const float* xmd = mod + (size_t)row_batch(xrow) * (6 * D);
        { const float* src = xs + (size_t)(xrow - MP) * D + xcol;
          ax[0] = *(const f32x4*)src + *(const f32x4*)(xmd + 2 * D + xcol) * ax[0]; ax[1] = *(const f32x4*)(src + 4) + *(const f32x4*)(xmd + 2 * D + xcol + 4) * ax[1]; }
        rowstat_big(st, acc, ax, u, wr, wc, fr, fq);
        const LAS float* S = st.tab + 1024;
        { *(u32x4*)(X1 + (size_t)xrow * D + xcol) = pack8(ax[0], ax[1]); h2_store(xrow, xcol, xmd, S[256 + fr], ax[0], ax[1]); }
        f32x4 sc[2][2], sh[2][2];
#pragma unroll
        for (int bj = 0; bj < 2; ++bj)
#pragma unroll
            for (int n = 0; n < 2; ++n) { const int col = cw + bj * 128 + 4 * n;
                sc[bj][n] = *(const f32x4*)(n2g + col) * (*(const f32x4*)(md + 4 * D + col) + 1.0f); sh[bj][n] = *(const f32x4*)(md + 3 * D + col); }
#pragma unroll
        for (int ai = 0; ai < 2; ++ai)
#pragma unroll
            for (int m = 0; m < 4; ++m) { const int row = EPI_ROWS(ai, m); const float rstd = S[ai * 128 + wr * 64 + m * 16 + fr];
#pragma unroll
                for (int bj = 0; bj < 2; ++bj) { *(u32x4*)(X1 + (size_t)row * D + cw + bj * 128) = pack8(acc[ai][bj][m][0], acc[ai][bj][m][1]);
                    *(u32x4*)(H2 + (size_t)row * D + cw + bj * 128) = pack8(acc[ai][bj][m][0] * rstd * sc[bj][0] + sh[bj][0], acc[ai][bj][m][1] * rstd * sc[bj][1] + sh[bj][1]); } }
        return false;
    }
};
template <bool XS> struct EpiG5N {
    const bf16_t* X1; float* OUT; const float* mod; const float* fg; RowStat st; const unsigned* btmo;
    __device__ __forceinline__ bool operator()(Acc& acc, f32x4 (&ax)[2], const Unit& u, int wr, int wc, int fr, int fq) const {
        const int cw = u.pn * 256 + wc * 32 + 8 * fq; const float* md = mod + (size_t)(u.pm >> 3) * (6 * D) + 5 * D;
        {   f32x4 gg[2][2];
#pragma unroll
            for (int bj = 0; bj < 2; ++bj) { gg[bj][0] = *(const f32x4*)(md + cw + bj * 128); gg[bj][1] = *(const f32x4*)(md + cw + bj * 128 + 4); }
#pragma unroll
            for (int ai = 0; ai < 2; ++ai)
#pragma unroll
                for (int m = 0; m < 4; ++m) { const int row = EPI_ROWS(ai, m);
#pragma unroll
                    for (int bj = 0; bj < 2; ++bj) { f32x4 x0, x1; unpack8(*(const u32x4*)(X1 + (size_t)row * D + cw + bj * 128), x0, x1);
                        acc[ai][bj][m][0] = x0 + gg[bj][0] * acc[ai][bj][m][0]; acc[ai][bj][m][1] = x1 + gg[bj][1] * acc[ai][bj][m][1]; }
                    asm volatile("" : "+v"(acc[ai][0][m][0]), "+v"(acc[ai][0][m][1]), "+v"(acc[ai][1][m][0]), "+v"(acc[ai][1][m][1]));
                    if (m & 1) asm volatile("" ::: "memory"); }
        }
        const int xrow = MP + 16 * u.pm + fr, xcol = cw + wr * 128; float* xo = OUT + (size_t)xrow * D + xcol;
        if constexpr (XS) { const float* xg = mod + (size_t)row_batch(xrow) * (6 * D) + 5 * D + xcol; f32x4 x0, x1; unpack8(*(const u32x4*)(X1 + (size_t)xrow * D + xcol), x0, x1);
          ax[0] = x0 + *(const f32x4*)xg * ax[0]; ax[1] = x1 + *(const f32x4*)(xg + 4) * ax[1]; }
        rowstat_big(st, acc, ax, u, wr, wc, fr, fq);
        const LAS float* S = st.tab + 1024; const float poison = (xb_ld((unsigned*)btmo) | xb_ld(st.tmo)) ? __builtin_nanf("") : 1.0f;
        f32x4 fgv[2][2];
#pragma unroll
        for (int bj = 0; bj < 2; ++bj) { fgv[bj][0] = *(const f32x4*)(fg + cw + bj * 128); fgv[bj][1] = *(const f32x4*)(fg + cw + bj * 128 + 4); }
        if constexpr (XS) { const float rx = S[256 + fr] * poison; *(f32x4*)xo = ax[0] * rx * (wr ? fgv[1][0] : fgv[0][0]); *(f32x4*)(xo + 4) = ax[1] * rx * (wr ? fgv[1][1] : fgv[0][1]); }
#pragma unroll
        for (int ai = 0; ai < 2; ++ai)
#pragma unroll
            for (int m = 0; m < 4; ++m) { const int row = EPI_ROWS(ai, m); const float rstd = S[ai * 128 + wr * 64 + m * 16 + fr] * poison;
#pragma unroll
                for (int bj = 0; bj < 2; ++bj) { float* o = OUT + (size_t)row * D + cw + bj * 128;
                    *(f32x4*)o = acc[ai][bj][m][0] * rstd * fgv[bj][0]; *(f32x4*)(o + 4) = acc[ai][bj][m][1] * rstd * fgv[bj][1]; } }
        return false;
    }
};
#define DPP_F(old, src, ctrl) __builtin_bit_cast(float, __builtin_amdgcn_update_dpp(__builtin_bit_cast(int, (float)(old)), __builtin_bit_cast(int, (float)(src)), (ctrl), 0xf, 0xf, false))
#define DPP_ROT(src, ctrl) __builtin_bit_cast(float, __builtin_amdgcn_mov_dpp(__builtin_bit_cast(int, (float)(src)), (ctrl), 0xf, 0xf, true))
constexpr int XL_OFF = 131072;
struct EpiG4F {
    bf16_t* GB; float* out; float* side_last; float* side_first; const float* fcw; const float* sffn; LAS float* xl;
    __device__ __forceinline__ bool operator()(Acc& acc, f32x4 (&ax)[2], const Unit& u, int wr, int wc, int fr, int fq) const {
        const int col = u.pn * 128 + wc * 32 + 8 * fq; const bool samp = u.pm >= 64;
        if (fr >= 14) {
#pragma unroll
            for (int ai = 0; ai < 2; ++ai)
#pragma unroll
                for (int n = 0; n < 2; ++n) *(LAS f32x4*)(xl + (((wr * 4 + wc) * 2 + ai) * 2 + (fr - 14)) * 32 + fq * 8 + n * 4) = acc[ai][0][3][n];
            if (wr == 1) { float* sl = side_last + ((size_t)u.pm * 2 + (fr - 14)) * DFF + col; *(f32x4*)sl = acc[1][0][3][0]; *(f32x4*)(sl + 4) = acc[1][0][3][1]; }
        }
        if (wr == 0 && fr < 2) { float* sf = side_first + ((size_t)u.pm * 2 + fr) * 2 * DFF + col;
            *(f32x4*)sf = acc[0][0][0][0]; *(f32x4*)(sf + 4) = acc[0][0][0][1]; *(f32x4*)(sf + DFF) = acc[0][1][0][0]; *(f32x4*)(sf + DFF + 4) = acc[0][1][0][1]; }
        asm volatile("s_waitcnt lgkmcnt(0)" ::: "memory"); __builtin_amdgcn_s_barrier(); asm volatile("" ::: "memory");
        const f32x4 w0a = *(const f32x4*)(fcw + col), w0b = *(const f32x4*)(fcw + col + 4), w1a = *(const f32x4*)(fcw + DFF + col), w1b = *(const f32x4*)(fcw + DFF + col + 4),
                    w2a = *(const f32x4*)(fcw + 2 * DFF + col), w2b = *(const f32x4*)(fcw + 2 * DFF + col + 4);
        f32x4 ror1p[2], ror2p[2];
#pragma unroll
        for (int ai = 0; ai < 2; ++ai)
#pragma unroll
            for (int m = 0; m < 4; ++m) { const int row = EPI_ROWS(ai, m);
                { bool st_ = false; size_t so_ = 0;
                  if (!samp) { const int t = row & 2047; if (t >= 2046) { st_ = true; so_ = O_FFN_P + (size_t)((row >> 11) * 2 + (t - 2046)) * DFF + col; } }
                  else { const int rs = row - MP, t = rs & 7; if (t >= 6) { st_ = true; so_ = O_FFN_S + (size_t)((rs >> 3) * 2 + (t - 6)) * DFF + col; } }
                  if (st_) { NT_ST(acc[ai][0][m][0], (f32x4*)(out + so_)); NT_ST(acc[ai][0][m][1], (f32x4*)(out + so_ + 4)); } }
                if (m == 0) {
                    f32x4 pv[2];
                    if (wr == 1 || ai == 1) { const LAS float* src = xl + ((((wr == 1 ? 0 : 1) * 4 + wc) * 2 + (wr == 1 ? ai : 0)) * 2 + (fr & 1)) * 32 + fq * 8;
                        pv[0] = *(const LAS f32x4*)src; pv[1] = *(const LAS f32x4*)(src + 4); }
                    else { pv[0] = (f32x4){0.f, 0.f, 0.f, 0.f}; pv[1] = pv[0]; }
#pragma unroll
                    for (int n = 0; n < 2; ++n)
#pragma unroll
                        for (int e = 0; e < 4; ++e) { ror1p[n][e] = DPP_ROT(pv[n][e], 0x121); ror2p[n][e] = DPP_ROT(pv[n][e], 0x122); }
                }
                f32x4 p1[2], p2[2];
#pragma unroll
                for (int n = 0; n < 2; ++n)
#pragma unroll
                    for (int e = 0; e < 4; ++e) { const float x = acc[ai][0][m][n][e];
                        const float r1 = DPP_ROT(x, 0x121), r2 = DPP_ROT(x, 0x122);
                        p1[n][e] = fr == 0 ? ror1p[n][e] : r1; p2[n][e] = fr < 2 ? ror2p[n][e] : r2;
                        ror1p[n][e] = r1; ror2p[n][e] = r2; }
                if (samp) { const int rs = row - MP, t = rs & 7;
                    if (t < 2) { const float* h = sffn + (size_t)(rs >> 3) * 2 * DFF + col;
                        const f32x4 h1a = *(const f32x4*)(h + DFF), h1b = *(const f32x4*)(h + DFF + 4);
                        if (t == 0) { p2[0] = *(const f32x4*)h; p2[1] = *(const f32x4*)(h + 4); p1[0] = h1a; p1[1] = h1b; } else { p2[0] = h1a; p2[1] = h1b; } } }
                const f32x4 c0 = w0a * p2[0] + w1a * p1[0] + w2a * acc[ai][0][m][0], c1 = w0b * p2[1] + w1b * p1[1] + w2b * acc[ai][0][m][1];
                const f32x2 g0 = gelu_pk((f32x2){c0[0], c0[1]}), g1 = gelu_pk((f32x2){c0[2], c0[3]}), g2 = gelu_pk((f32x2){c1[0], c1[1]}), g3 = gelu_pk((f32x2){c1[2], c1[3]});
                const f32x4 y0 = (f32x4){g0.x, g0.y, g1.x, g1.y} * acc[ai][1][m][0], y1 = (f32x4){g2.x, g2.y, g3.x, g3.y} * acc[ai][1][m][1];
                *(u32x4*)(GB + (size_t)row * DFF + col) = pack8(y0, y1);
                asm volatile("" ::: "memory"); }
        return false;
    }
};
__device__ __forceinline__ void ffn_fixup(int pm, bf16_t* GB, const float* side_last, const float* side_first, const float* fcw) {
    for (int e = threadIdx.x; e < 2 * DFF; e += 512) { const int r = e / DFF, j = e % DFF;
        const float* sf = side_first + (size_t)pm * 4 * DFF; const float* sl = side_last + (size_t)(pm - 1) * 2 * DFF;
        const float a0 = sf[(size_t)r * 2 * DFF + j], v = sf[(size_t)r * 2 * DFF + DFF + j];
        const float am1 = r == 0 ? sl[DFF + j] : sf[j], am2 = r == 0 ? sl[j] : sl[DFF + j];
        const f32x2 gl = gelu_pk((f32x2){fcw[j] * am2 + fcw[DFF + j] * am1 + fcw[2 * DFF + j] * a0, 0.f});
        GB[(size_t)(pm * 256 + r) * DFF + j] = (bf16_t)f2bf(gl.x * v); }
}

__device__ __forceinline__ int dst_row(int map, int n) {
    if (map == 1) {
        if (n < 1024) return 2048 + n;
        if (n < 2048) return 256 * ((n - 1024) >> 7) + (n & 127);
        if (n < 3072) return 256 * ((n - 2048) >> 7) + 128 + (n & 127);
        if (n < 4608) return n;
        if (n < 5632) return 4608 + 256 * ((n - 4608) >> 7) + (n & 127);
        return 4608 + 256 * ((n - 5632) >> 7) + 128 + (n & 127);
    }
    if (map == 2) {
        if (n < DFF) return 256 * (n >> 7) + (n & 127);
        const int mm = n - DFF; return 256 * (mm >> 7) + 128 + (mm & 127);
    }
    return n;
}
struct TItem { const float* W; bf16_t* WT; int K, N, map, item; };
__device__ __forceinline__ void titem_load(const TItem& t, int lane, float (&tv)[32]) {
    const int nblk = t.N / 32, kb = t.item / nblk, nb = t.item % nblk, k0 = 64 * kb, n0 = 32 * nb;
#pragma unroll
    for (int i = 0; i < 32; ++i) { const int kk = 2 * i + (lane >> 5); tv[i] = __builtin_nontemporal_load(t.W + (size_t)(k0 + kk) * t.N + n0 + (lane & 31)); }
}
__device__ __forceinline__ void titem_finish(const TItem& t, int lane, const float (&tv)[32], LAS float* scr) {
    const int nblk = t.N / 32, kb = t.item / nblk, nb = t.item % nblk, k0 = 64 * kb, n0 = 32 * nb;
#pragma unroll
    for (int i = 0; i < 32; ++i) { const int kk = 2 * i + (lane >> 5); scr[kk * 33 + (lane & 31)] = tv[i]; }
    asm volatile("s_waitcnt lgkmcnt(0)" ::: "memory");
    const int c = lane & 7, r0 = dst_row(t.map, n0);
#pragma unroll
    for (int j = 0; j < 4; ++j) { const int n = (lane >> 3) + 8 * j; const LAS float* sp = scr + (8 * c) * 33 + n;
        u32x4 o; o.x = pk2(sp[0 * 33], sp[1 * 33]); o.y = pk2(sp[2 * 33], sp[3 * 33]); o.z = pk2(sp[4 * 33], sp[5 * 33]); o.w = pk2(sp[6 * 33], sp[7 * 33]);
        *(u32x4*)(t.WT + (size_t)(r0 + n) * t.K + k0 + 8 * c) = o; }
    asm volatile("s_waitcnt lgkmcnt(0)" ::: "memory");
}
constexpr int WC_NV4 = NBS * (WIN - DSEQ) * KVW / 4, WC_PER = (WIN - DSEQ) * KVW / 4;
#define WCOPY_SRC(pk_, i) ((const f32x4*)((const float*)(pk_)->in[(i) >= WC_NV4 ? I_CV : I_CK] + ((size_t)(((i) >= WC_NV4 ? (i) - WC_NV4 : (i)) / WC_PER) * WIN + DSEQ) * KVW) + ((i) >= WC_NV4 ? (i) - WC_NV4 : (i)) % WC_PER)
#define WCOPY_DST(pk_, i) ((f32x4*)((float*)(pk_)->out + ((i) >= WC_NV4 ? O_V_S : O_K_S) + (size_t)(((i) >= WC_NV4 ? (i) - WC_NV4 : (i)) / WC_PER) * WIN * KVW) + ((i) >= WC_NV4 ? (i) - WC_NV4 : (i)) % WC_PER)
template <class PK> __device__ __forceinline__ void mod_phase(PK pk_, LAS unsigned char* L, float* mod, long gt, long GT) {
    struct { const float* in[22]; } p; p.in[I_WADA] = (const float*)pk_->in[I_WADA]; p.in[I_CP] = (const float*)pk_->in[I_CP]; p.in[I_CS] = (const float*)pk_->in[I_CS]; p.in[I_BADA] = (const float*)pk_->in[I_BADA];
    constexpr int WT_PITCH = 2064, WT_BYTES = 32 * WT_PITCH, AS_PITCH = 272, AS_BYTES = 144 * AS_PITCH;
    static_assert(WT_BYTES + 2 * AS_BYTES <= MISC_OFF, "mod LDS");
    int tid = threadIdx.x; asm volatile("" : "+v"(tid));
    const int lane = tid & 63, wave = __builtin_amdgcn_readfirstlane(tid >> 6), fr = lane & 15, fq = lane >> 4;
    const float* w_ada = p.in[I_WADA];
    for (int cgp = blockIdx.x; cgp < 256; cgp += gridDim.x) {
        __syncthreads();
        f32x4 wv[12];
#pragma unroll
        for (int i = 0; i < 12; ++i) { const int q = tid + 512 * i, k = q / 6, c4 = q % 6; wv[i] = NT_LD((const f32x4*)(w_ada + (size_t)k * (6 * D) + cgp * 24 + 4 * c4)); }
        f32x4 cv[9];
#define MOD_LOADA(k0) do { _Pragma("unroll") for (int i = 0; i < 9; ++i) { const int f = tid + 512 * i, row = f >> 5, c4 = f & 31; \
            if (f < NBATCH * 32) cv[i] = *(const f32x4*)((row < NBP ? p.in[I_CP] + (size_t)row * D : p.in[I_CS] + (size_t)(row - NBP) * D) + (k0) + 4 * c4); } } while (0)
#define MOD_STOREA(buf) do { _Pragma("unroll") for (int i = 0; i < 9; ++i) { const int f = tid + 512 * i, row = f >> 5, c4 = f & 31; \
            if (f < NBATCH * 32) { f32x4 v = cv[i]; _Pragma("unroll") for (int e = 0; e < 4; ++e) v[e] = v[e] * sigmoidf_(v[e]); \
                *(LAS u32x2*)(L + WT_BYTES + (buf) * AS_BYTES + row * AS_PITCH + c4 * 8) = (u32x2){cvtpk_s(v[0], v[1]), cvtpk_s(v[2], v[3])}; } } } while (0)
        MOD_LOADA(0);
#pragma unroll
        for (int i = 0; i < 12; ++i) { const int q = tid + 512 * i, k = q / 6, c4 = q % 6;
#pragma unroll
            for (int e = 0; e < 4; ++e) *(LAS bf16_t*)(L + (4 * c4 + e) * WT_PITCH + k * 2) = (bf16_t)f2bf(wv[i][e]); }
        MOD_STOREA(0);
        __syncthreads();
        f32x4 acc[2][2];
#pragma unroll
        for (int a = 0; a < 2; ++a)
#pragma unroll
            for (int b = 0; b < 2; ++b) acc[a][b] = (f32x4){0.f, 0.f, 0.f, 0.f};
        f32x4 wcp[2], wcq[2];
#pragma unroll 1
        for (int ch = 0; ch < D / 128; ++ch) {
            if (cgp == (int)blockIdx.x) {
#pragma unroll
                for (int q = 0; q < 2; ++q) { const int i = (int)gt + (2 * ch + q) * (int)GT; if (i < 2 * WC_NV4) wcq[q] = __builtin_nontemporal_load(WCOPY_SRC(pk_, i)); }
                if (ch > 0) {
#pragma unroll
                    for (int q = 0; q < 2; ++q) { const int i = (int)gt + (2 * (ch - 1) + q) * (int)GT; if (i < 2 * WC_NV4) __builtin_nontemporal_store(wcp[q], WCOPY_DST(pk_, i)); } }
            }
            if (ch + 1 < D / 128) { MOD_LOADA((ch + 1) * 128); } __builtin_amdgcn_sched_barrier(0);
            const LAS unsigned char* As = L + WT_BYTES + (ch & 1) * AS_BYTES;
#pragma unroll
            for (int ks = 0; ks < 4; ++ks) {
                const bf16x8 b0 = *(const LAS bf16x8*)(L + fr * WT_PITCH + (ch * 128 + ks * 32 + fq * 8) * 2), b1 = *(const LAS bf16x8*)(L + (16 + fr) * WT_PITCH + (ch * 128 + ks * 32 + fq * 8) * 2);
                const bf16x8 a0 = *(const LAS bf16x8*)(As + (wave * 16 + fr) * AS_PITCH + ks * 64 + fq * 16);
                acc[0][0] = __builtin_amdgcn_mfma_f32_16x16x32_bf16(a0, b0, acc[0][0], 0, 0, 0);
                acc[0][1] = __builtin_amdgcn_mfma_f32_16x16x32_bf16(a0, b1, acc[0][1], 0, 0, 0);
                if (wave == 0) { const bf16x8 a1 = *(const LAS bf16x8*)(As + (128 + fr) * AS_PITCH + ks * 64 + fq * 16);
                    acc[1][0] = __builtin_amdgcn_mfma_f32_16x16x32_bf16(a1, b0, acc[1][0], 0, 0, 0);
                    acc[1][1] = __builtin_amdgcn_mfma_f32_16x16x32_bf16(a1, b1, acc[1][1], 0, 0, 0); }
            }
            if (ch + 1 < D / 128) MOD_STOREA((ch + 1) & 1);
            wcp[0] = wcq[0]; wcp[1] = wcq[1];
            __syncthreads();
        }
        if (cgp == (int)blockIdx.x) {
#pragma unroll
            for (int q = 0; q < 2; ++q) { const int i = (int)gt + (2 * (D / 128 - 1) + q) * (int)GT; if (i < 2 * WC_NV4) __builtin_nontemporal_store(wcp[q], WCOPY_DST(pk_, i)); } }
#undef MOD_LOADA
#undef MOD_STOREA
#pragma unroll
        for (int a = 0; a < 2; ++a) { if (a == 1 && wave != 0) continue; const int rb = a == 0 ? wave : 8;
#pragma unroll
            for (int nb = 0; nb < 2; ++nb) { const int cc = 16 * nb + fr; if (cc < 24) { const float bb = p.in[I_BADA][cgp * 24 + cc];
#pragma unroll
                for (int reg = 0; reg < 4; ++reg) { const int row = rb * 16 + 4 * fq + reg; if (row < NBATCH) mod[(size_t)row * (6 * D) + cgp * 24 + cc] = acc[a][nb][reg] + bb; } } } }
    }
    __syncthreads();
}
namespace att {
constexpr int SLOT = 8192, NSLOT = 6;
constexpr int L_K = 0, L_V = NSLOT * SLOT, L_WS = 2 * NSLOT * SLOT, L_OST = L_WS + 2048, L_END = L_OST + NWAVES * 4096;
static_assert(L_END <= MISC_OFF, "attention LDS");
constexpr float NEG = -1e30f;
__device__ __forceinline__ int crow(int r, int hi) { return (r & 3) + 8 * (r >> 2) + 4 * hi; }
typedef short v4i16_t __attribute__((ext_vector_type(4)));
__device__ __forceinline__ s16x4 vtr(const LAS char* p) { return __builtin_bit_cast(s16x4, __builtin_amdgcn_ds_read_tr16_b64_v4i16((LAS v4i16_t*)p)); }

__device__ __forceinline__ void attn_sub(const LAS char* Kb, const LAS char* Vb, int t0, const bf16x8 (&qr)[4], int qi, int jmin, float slope2, float sink2,
                                         f32x16 (&o)[2], float& l_out, int lane) {
    const int r32 = lane & 31, hi = lane >> 5;
    const int lo = qi > jmin ? qi : jmin, hiq = qi + WIN;
    f32x16 P[3][2];
#pragma unroll
    for (int tt = 0; tt < 3; ++tt) {
        const int jb = 64 * (t0 + tt) + 4 * hi; const float A = slope2 * (float)(jb - WIN - qi);
        const int lo_rel = lo - jb, hi_rel = hiq - jb;
#pragma unroll
        for (int r = 0; r < 16; ++r) { const int off = (r & 3) + 8 * (r >> 2);
            float b0 = fmaf(slope2, (float)off, A), b1 = fmaf(slope2, (float)(off + 32), A);
            if (tt == 0 || (tt == 1 && jmin != 0)) { b0 = off >= lo_rel ? b0 : NEG; b1 = off + 32 >= lo_rel ? b1 : NEG; }
            if (tt == 2) { b0 = off <= hi_rel ? b0 : NEG; b1 = off + 32 <= hi_rel ? b1 : NEG; }
            P[tt][0][r] = b0; P[tt][1][r] = b1; }
        const LAS char* kp = Kb + (t0 + tt) * SLOT + hi * 1024 + r32 * 16;
#pragma unroll
        for (int d0 = 0; d0 < 4; ++d0) {
            const bf16x8 b0 = *(const LAS bf16x8*)(kp + d0 * 2048), b1 = *(const LAS bf16x8*)(kp + d0 * 2048 + 512);
            P[tt][0] = __builtin_amdgcn_mfma_f32_32x32x16_bf16(b0, qr[d0], P[tt][0], 0, 0, 0);
            P[tt][1] = __builtin_amdgcn_mfma_f32_32x32x16_bf16(b1, qr[d0], P[tt][1], 0, 0, 0);
        }
    }
    float m = sink2;
#pragma unroll
    for (int tt = 0; tt < 3; ++tt)
#pragma unroll
        for (int r = 0; r < 16; ++r) m = fmaxf(m, fmaxf(P[tt][0][r], P[tt][1][r]));
    m = fmaxf(m, __shfl_xor(m, 32));
    float l = hi == 0 ? __builtin_amdgcn_exp2f(sink2 - m) : 0.f;
#pragma unroll
    for (int r = 0; r < 16; ++r) { o[0][r] = 0.f; o[1][r] = 0.f; }
    const int voff = ((lane >> 4) & 1) * 32 + (lane & 3) * 8 + (4 * hi + ((lane & 15) >> 2)) * 64;
#pragma unroll
    for (int tt = 0; tt < 3; ++tt) {
        float sum = 0.f;
#pragma unroll
        for (int r = 0; r < 16; ++r) { P[tt][0][r] = __builtin_amdgcn_exp2f(P[tt][0][r] - m); P[tt][1][r] = __builtin_amdgcn_exp2f(P[tt][1][r] - m); sum += P[tt][0][r] + P[tt][1][r]; }
        l += sum;
        u32x4 pw[4];
#pragma unroll
        for (int k = 0; k < 4; ++k) { pw[0][k] = cvtpk_s(P[tt][0][2 * k], P[tt][0][2 * k + 1]); pw[1][k] = cvtpk_s(P[tt][0][8 + 2 * k], P[tt][0][9 + 2 * k]);
                                      pw[2][k] = cvtpk_s(P[tt][1][2 * k], P[tt][1][2 * k + 1]); pw[3][k] = cvtpk_s(P[tt][1][8 + 2 * k], P[tt][1][9 + 2 * k]); }
        const LAS char* vp = Vb + (t0 + tt) * SLOT + voff;
#pragma unroll
        for (int d0 = 0; d0 < 2; ++d0)
#pragma unroll
            for (int ks = 0; ks < 4; ++ks) {
                const s16x4 lo4 = vtr(vp + d0 * 4096 + ks * 1024), hh = vtr(vp + d0 * 4096 + ks * 1024 + 512);
                const bf16x8 vf = {lo4[0], lo4[1], lo4[2], lo4[3], hh[0], hh[1], hh[2], hh[3]};
                o[d0] = __builtin_amdgcn_mfma_f32_32x32x16_bf16(__builtin_bit_cast(bf16x8, pw[ks]), vf, o[d0], 0, 0, 0);
            }
    }
    l_out = l + __shfl_xor(l, 32);
}
}

#define K_Wup ((bf16_t*)(ws + WS_WUP))
#define K_Wdn ((bf16_t*)(ws + WS_WDN))
#define K_Win ((bf16_t*)(ws + WS_WIN))
#define K_Wc ((bf16_t*)(ws + WS_WC))
#define K_Wa ((bf16_t*)(ws + WS_WA))
#define K_Wm ((bf16_t*)(ws + WS_WM))
#define K_Ub ((bf16_t*)(ws + WS_U))
#define K_BGb ((bf16_t*)(ws + WS_BG))
#define K_Qb ((bf16_t*)(ws + WS_Q))
#define K_SAb ((bf16_t*)(ws + WS_SA))
#define K_SBb ((bf16_t*)(ws + WS_SB))
#define K_Kb ((bf16_t*)(ws + WS_K))
#define K_Vb ((bf16_t*)(ws + WS_V))
#define K_H2 ((bf16_t*)(ws + WS_U))
#define K_VLb ((bf16_t*)(ws + WS_VAL))
#define K_H1 ((bf16_t*)((float*)pk->out + O_Y))
#define K_X1 ((bf16_t*)(ws + WS_Q))
#define K_OUT ((float*)pk->out + O_Y)
#define K_mod ((float*)(ws + WS_MOD))
__global__ void __launch_bounds__(NWAVES * 64, 2) fwd_kernel(KP p_unused) {
    extern __shared__ __attribute__((aligned(16))) unsigned char lds[];
    LAS unsigned char* L = (LAS unsigned char*)lds;
    volatile LAS unsigned* MISC = (volatile LAS unsigned*)(L + MISC_OFF);
    struct KPG { const float GAS* in[22]; float GAS* out; unsigned char GAS* ws; };
    typedef const KPG __attribute__((address_space(4))) CKP;
    const CKP* pk = (const CKP*)__builtin_amdgcn_kernarg_segment_ptr();
    unsigned char GAS* ws = pk->ws;
#define PHASE_BEGIN() do { asm volatile("" : "+s"(pk)); ws = pk->ws; asm volatile("" : "+s"(ws)); tid = threadIdx.x; asm volatile("" : "+v"(tid)); lane = tid & 63; gt = (long)blockIdx.x * 512 + tid; } while (0)
    int tid = threadIdx.x, lane = tid & 63; const int wave = __builtin_amdgcn_readfirstlane(tid >> 6);
    const int G = gridDim.x, bx = blockIdx.x;
    const int vcu = (G % 8 == 0) ? (bx % 8) * (G / 8) + bx / 8 : bx;
    if (tid < 32) MISC[tid] = 0u;
    __syncthreads();
    XcdBarrier bar = xcd_barrier_post((unsigned*)ws + CW_BAR, MISC + 8);
    const int gw = vcu * NWAVES + wave, NGW = G * NWAVES;
    long gt = (long)bx * 512 + tid; const long GT = (long)G * 512;

    mod_phase(pk, L, K_mod, gt, GT);
    asm volatile("s_waitcnt vmcnt(0)" ::: "memory"); __syncthreads();
    if (tid == 0) { __builtin_amdgcn_fence(__ATOMIC_RELEASE, "agent"); asm volatile("s_waitcnt vmcnt(0)" ::: "memory"); (void)xb_add((unsigned*)ws + CW_MODCNT, 1u); }
    {
        LAS float* scr = (LAS float*)(L + wave * 16384);
        constexpr int I_IN = (D / 64) * (NIN / 32), I_SQ = (D / 64) * (D / 32), I_UP = (D / 64) * (NUP / 32), I_DN = (DFF / 64) * (D / 32);
        constexpr int NITEMS = I_IN + 3 * I_SQ + I_UP + I_DN;
        auto pick = [&](int it, TItem& t) {
            int r = it;
            if (r < I_IN) { t = TItem{((const float*)pk->in[I_WIN]), K_Win, D, NIN, 1, r}; return; } r -= I_IN;
            if (r < I_SQ) { t = TItem{((const float*)pk->in[I_WCO]), K_Wc, D, D, 0, r}; return; } r -= I_SQ;
            if (r < I_SQ) { t = TItem{((const float*)pk->in[I_WAO]), K_Wa, D, D, 0, r}; return; } r -= I_SQ;
            if (r < I_SQ) { t = TItem{((const float*)pk->in[I_WMIX]), K_Wm, D, D, 0, r}; return; } r -= I_SQ;
            if (r < I_UP) { t = TItem{((const float*)pk->in[I_WUP]), K_Wup, D, NUP, 2, r}; return; } r -= I_UP;
            t = TItem{((const float*)pk->in[I_WDN]), K_Wdn, DFF, D, 0, r}; };
        float tva[32], tvb[32]; TItem ta, tb;
        int it = gw;
        if (it < NITEMS) { pick(it, ta); titem_load(ta, lane, tva); }
        while (it < NITEMS) {
            const int it2 = it + NGW;
            if (it2 < NITEMS) { pick(it2, tb); titem_load(tb, lane, tvb); }
            __builtin_amdgcn_sched_barrier(0);
            titem_finish(ta, lane, tva, scr);
            if (it2 >= NITEMS) break;
            const int it3 = it2 + NGW;
            if (it3 < NITEMS) { pick(it3, ta); titem_load(ta, lane, tva); }
            __builtin_amdgcn_sched_barrier(0);
            titem_finish(tb, lane, tvb, scr);
            it = it3;
        }
        for (int i = (int)gt + 16 * (int)GT; i < 2 * WC_NV4; i += (int)GT) __builtin_nontemporal_store(__builtin_nontemporal_load(WCOPY_SRC(pk, i)), WCOPY_DST(pk, i));
    }
    if (tid == 0) { unsigned* cw = (unsigned*)ws + CW_MODCNT; unsigned* tm = (unsigned*)ws + CW_BAR + XB_TMO; unsigned sp = 0;
        while (xb_ld(cw) < (unsigned)G) { __builtin_amdgcn_s_sleep(2); if ((++sp & 255u) == 0u) { if (xb_ld(tm)) break; if (sp > XB_SPIN_CAP) { atomicAdd(tm, 1u); break; } } }
        __builtin_amdgcn_fence(__ATOMIC_ACQUIRE, "agent"); asm volatile("s_waitcnt vmcnt(0)" ::: "memory"); }
    __syncthreads();

    {
        const int rpw = (M + NGW - 1) / NGW, m0 = gw * rpw, m1 = (m0 + rpw < M) ? m0 + rpw : M;
        f32x4 ga[4], ca[4], ha[4], xv[4], xn[4]; int curb = -1;
#pragma unroll
        for (int j = 0; j < 4; ++j) ga[j] = ((const f32x4*)((const float*)pk->in[I_N1G]))[lane + 64 * j];
        auto xrow = [&](int m) { return (const f32x4*)(m < MP ? ((const float*)pk->in[I_XP]) + (size_t)m * D : ((const float*)pk->in[I_XS]) + (size_t)(m - MP) * D) + lane; };
        if (m0 < m1) { const f32x4* xr = xrow(m0);
#pragma unroll
            for (int j = 0; j < 4; ++j) xv[j] = __builtin_nontemporal_load(xr + 64 * j); }
        for (int m = m0; m < m1; ++m) {
            if (m + 1 < m1) { const f32x4* xr = xrow(m + 1);
#pragma unroll
                for (int j = 0; j < 4; ++j) xn[j] = __builtin_nontemporal_load(xr + 64 * j); }
            __builtin_amdgcn_sched_barrier(0);
            const int b = row_batch(m);
            if (b != curb) { curb = b; const float* md = K_mod + (size_t)b * (6 * D);
#pragma unroll
                for (int j = 0; j < 4; ++j) { ca[j] = ((const f32x4*)(md + D))[lane + 64 * j] + 1.0f; ha[j] = ((const f32x4*)md)[lane + 64 * j]; } }
            float ss = 0.f;
#pragma unroll
            for (int j = 0; j < 4; ++j) ss += (xv[j].x * xv[j].x + xv[j].y * xv[j].y) + (xv[j].z * xv[j].z + xv[j].w * xv[j].w);
            const float rstd = 1.0f / sqrtf(wave_sum(ss) * (1.f / D) + RMS_EPS);
            unsigned long long* o8 = (unsigned long long*)(K_H1 + (size_t)m * D) + lane;
#pragma unroll
            for (int j = 0; j < 4; ++j) { const f32x4 y = xv[j] * rstd * ga[j] * ca[j] + ha[j];
                o8[64 * j] = (unsigned long long)pk2(y.x, y.y) | ((unsigned long long)pk2(y.z, y.w) << 32); }
#pragma unroll
            for (int j = 0; j < 4; ++j) xv[j] = xn[j];
        }
    }
    xcd_barrier(bar);
    PHASE_BEGIN();

    { SchedPlain S{(const char*)K_H1, (const char*)K_Win, M / 256, NIN / 256, G, bx, (size_t)256 * D * 2};
      EpiG1 E{K_Ub, K_BGb, K_Qb, K_Kb, K_Vb, K_SAb, K_SBb, ((float*)pk->out)};
      pg8::gemm_phase<EpiG1, SchedPlain, false>(L, D, S, E); }
    xcd_barrier(bar);
    PHASE_BEGIN();

    {
        using namespace att;
        const LAS char* Kl = (const LAS char*)(L + L_K); const LAS char* Vl = (const LAS char*)(L + L_V);
        LAS float* wsf = (LAS float*)(L + L_WS) + wave * 64;
        LAS bf16_t* stg = (LAS bf16_t*)(L + L_OST) + wave * 2048;
        const int r32 = lane & 31, hi = lane >> 5;
        const float* sinks = ((const float*)pk->in[I_SINK]);
        for (int un_ = vcu; un_ < 512 + 256; un_ += G) { const int un = un_ < 256 ? 512 + un_ : un_ - 256;
            __syncthreads();
            if (un < 512) {
                const int b = un >> 6, kvh = (un >> 4) & 3, qb = un & 15;
                const long row0 = (long)b * SEQ + qb * WIN - WIN;
                {
                    u32x4 kv[4], vv[4];
#pragma unroll
                    for (int s = 0; s < 4; ++s) { const long kr = row0 + 64 * s + lane; const long vr = row0 + 64 * s + 16 * (wave & 3) + (lane >> 2);
                        kv[s] = (u32x4){0u, 0u, 0u, 0u}; vv[s] = (u32x4){0u, 0u, 0u, 0u};
                        if (qb > 0 || s >= 2) { kv[s] = *(const u32x4*)(K_Kb + (size_t)kr * KVW + kvh * 64 + wave * 8);
                                                vv[s] = *(const u32x4*)(K_Vb + (size_t)vr * KVW + kvh * 64 + (wave >> 2) * 32 + (lane & 3) * 8); } }
#pragma unroll
                    for (int s = 0; s < 4; ++s) { *(LAS u32x4*)(L + L_K + s * SLOT + wave * 1024 + lane * 16) = kv[s]; *(LAS u32x4*)(L + L_V + s * SLOT + wave * 1024 + lane * 16) = vv[s]; }
                }
                __syncthreads();
                const int g = wave >> 1, rh = wave & 1, head = kvh * 4 + g;
                const float slope2 = __builtin_amdgcn_exp2f(-0.5f * (float)(head + 1)) * LOG2E, sink2 = sinks[head] * LOG2E;
#pragma unroll 1
                for (int sb = 0; sb < 2; ++sb) {
                    const int i0 = 64 * rh + 32 * sb; const long qrow = (long)b * SEQ + qb * WIN + i0;
                    bf16x8 qr[4];
#pragma unroll
                    for (int d0 = 0; d0 < 4; ++d0) qr[d0] = *(const bf16x8*)(K_Qb + (size_t)(qrow + r32) * D + head * 64 + d0 * 16 + hi * 8);
                    f32x16 o[2]; float lt;
                    attn_sub(Kl, Vl, i0 >= 64 ? 1 : 0, qr, i0 + r32, qb == 0 ? WIN : 0, slope2, sink2, o, lt, lane);
                    if (hi == 0) wsf[32 + r32] = lt;
                    asm volatile("s_waitcnt lgkmcnt(0)" ::: "memory");
#pragma unroll
                    for (int r = 0; r < 16; ++r) { const int orow = crow(r, hi); const float rl = __builtin_amdgcn_rcpf(wsf[32 + orow]);
                        stg[orow * 64 + r32] = (bf16_t)f2bf(o[0][r] * rl); stg[orow * 64 + 32 + r32] = (bf16_t)f2bf(o[1][r] * rl); }
                    asm volatile("s_waitcnt lgkmcnt(0)" ::: "memory");
#pragma unroll
                    for (int i = 0; i < 4; ++i) { const int row = i * 8 + (lane >> 3), ch = lane & 7; const u32x4 v = *(const LAS u32x4*)(stg + row * 64 + ch * 8);
                        *(u32x4*)(K_Qb + (size_t)(qrow + row) * D + head * 64 + ch * 8) = v; }
                    asm volatile("s_waitcnt lgkmcnt(0)" ::: "memory");
                }
            } else {
                const int u2 = un - 512;
#pragma unroll
                for (int ti = 0; ti < 2; ++ti) { const int task = 2 * u2 + ti, b = task >> 2, kvh = task & 3;
                    const float* ck = ((const float*)pk->in[I_CK]) + (size_t)b * WIN * KVW + kvh * 64; const float* cv = ((const float*)pk->in[I_CV]) + (size_t)b * WIN * KVW + kvh * 64;
                    const int vc = (wave >> 2) * 32 + (lane & 3) * 8;
                    f32x4 ka[2][2], va[2][2]; u32x4 kn = {0u, 0u, 0u, 0u}, vn = {0u, 0u, 0u, 0u};
#pragma unroll
                    for (int s = 0; s < 2; ++s) { const int kk = 64 * s + lane, vk = 64 * s + 16 * (wave & 3) + (lane >> 2);
                        ka[s][0] = NT_LD((const f32x4*)(ck + (size_t)kk * KVW + wave * 8)); ka[s][1] = NT_LD((const f32x4*)(ck + (size_t)kk * KVW + wave * 8 + 4));
                        va[s][0] = NT_LD((const f32x4*)(cv + (size_t)vk * KVW + vc)); va[s][1] = NT_LD((const f32x4*)(cv + (size_t)vk * KVW + vc + 4)); }
                    if (lane < DSEQ) kn = *(const u32x4*)(K_Kb + (size_t)(MP + b * DSEQ + lane) * KVW + kvh * 64 + wave * 8);
                    { const int vk = 16 * (wave & 3) + (lane >> 2); if (vk < DSEQ) vn = *(const u32x4*)(K_Vb + (size_t)(MP + b * DSEQ + vk) * KVW + kvh * 64 + vc); }
#pragma unroll
                    for (int s = 0; s < 2; ++s) {
                        *(LAS u32x4*)(L + L_K + (3 * ti + s) * SLOT + wave * 1024 + lane * 16) = (u32x4){pk2(ka[s][0].x, ka[s][0].y), pk2(ka[s][0].z, ka[s][0].w), pk2(ka[s][1].x, ka[s][1].y), pk2(ka[s][1].z, ka[s][1].w)};
                        *(LAS u32x4*)(L + L_V + (3 * ti + s) * SLOT + wave * 1024 + lane * 16) = (u32x4){pk2(va[s][0].x, va[s][0].y), pk2(va[s][0].z, va[s][0].w), pk2(va[s][1].x, va[s][1].y), pk2(va[s][1].z, va[s][1].w)}; }
                    *(LAS u32x4*)(L + L_K + (3 * ti + 2) * SLOT + wave * 1024 + lane * 16) = kn; *(LAS u32x4*)(L + L_V + (3 * ti + 2) * SLOT + wave * 1024 + lane * 16) = vn; }
                __syncthreads();
                if (wave < 2) { const int task = 2 * u2 + wave, b = task >> 2, kvh = task & 3;
                    const int head = kvh * 4 + (r32 >> 3), tq = r32 & 7; const long qrow = MP + (long)b * DSEQ + tq;
                    const float slope2 = __builtin_amdgcn_exp2f(-0.5f * (float)(head + 1)) * LOG2E, sink2 = sinks[head] * LOG2E;
                    bf16x8 qr[4];
#pragma unroll
                    for (int d0 = 0; d0 < 4; ++d0) qr[d0] = *(const bf16x8*)(K_Qb + (size_t)qrow * D + head * 64 + d0 * 16 + hi * 8);
                    f32x16 o[2]; float lt;
                    attn_sub(Kl + 3 * wave * SLOT, Vl + 3 * wave * SLOT, 0, qr, tq, 0, slope2, sink2, o, lt, lane);
                    if (hi == 0) wsf[32 + r32] = lt;
                    asm volatile("s_waitcnt lgkmcnt(0)" ::: "memory");
#pragma unroll
                    for (int r = 0; r < 16; ++r) { const int orow = crow(r, hi); const float rl = __builtin_amdgcn_rcpf(wsf[32 + orow]);
                        stg[orow * 64 + r32] = (bf16_t)f2bf(o[0][r] * rl); stg[orow * 64 + 32 + r32] = (bf16_t)f2bf(o[1][r] * rl); }
                    asm volatile("s_waitcnt lgkmcnt(0)" ::: "memory");
#pragma unroll
                    for (int i = 0; i < 4; ++i) { const int row = i * 8 + (lane >> 3), ch = lane & 7; const u32x4 v = *(const LAS u32x4*)(stg + row * 64 + ch * 8);
                        *(u32x4*)(K_Qb + (size_t)(MP + (long)b * DSEQ + (row & 7)) * D + (kvh * 4 + (row >> 3)) * 64 + ch * 8) = v; }
                    asm volatile("s_waitcnt lgkmcnt(0)" ::: "memory");
                }
            }
        }
        {
            const float* cw = ((const float*)pk->in[I_CONVW]);
            const int c0 = (int)(gt & 127) * 8; const int nrb = (int)(GT >> 7), rb = (int)(gt >> 7);
            const int rpb = (M + nrb - 1) / nrb, r0 = rb * rpb, r1 = (r0 + rpb < M) ? r0 + rpb : M;
            const f32x4 w0a = *(const f32x4*)(cw + c0), w0b = *(const f32x4*)(cw + c0 + 4), w1a = *(const f32x4*)(cw + D + c0), w1b = *(const f32x4*)(cw + D + c0 + 4),
                        w2a = *(const f32x4*)(cw + 2 * D + c0), w2b = *(const f32x4*)(cw + 2 * D + c0 + 4);
            f32x4 p1a = {0.f, 0.f, 0.f, 0.f}, p1b = p1a, p2a = p1a, p2b = p1a;
            auto unp = [](const u32x4 w, f32x4& a, f32x4& b) { a = (f32x4){bflo(w.x), bfhi(w.x), bflo(w.y), bfhi(w.y)}; b = (f32x4){bflo(w.z), bfhi(w.z), bflo(w.w), bfhi(w.w)}; };
            if (r0 < r1) { const int t0 = r0 < MP ? (r0 & 2047) : ((r0 - MP) & 7);
                if (t0 >= 1) unp(*(const u32x4*)(K_Ub + (size_t)(r0 - 1) * D + c0), p1a, p1b);
                if (t0 >= 2) unp(*(const u32x4*)(K_Ub + (size_t)(r0 - 2) * D + c0), p2a, p2b);
                else if (t0 == 1 && r0 >= MP) { const float* sc = ((const float*)pk->in[I_SCONV]) + ((size_t)((r0 - MP) >> 3) * 2 + 1) * D + c0; p2a = *(const f32x4*)sc; p2b = *(const f32x4*)(sc + 4); } }
            u32x4 un = {0u, 0u, 0u, 0u}, gn = un;
            if (r0 < r1) { un = NT_LD((const u32x4*)(K_Ub + (size_t)r0 * D + c0)); gn = NT_LD((const u32x4*)(K_BGb + (size_t)r0 * D + c0)); }
            for (int row = r0; row < r1; ++row) {
                const u32x4 uw = un, gw4 = gn;
                if (row + 1 < r1) { un = NT_LD((const u32x4*)(K_Ub + (size_t)(row + 1) * D + c0)); gn = NT_LD((const u32x4*)(K_BGb + (size_t)(row + 1) * D + c0)); }
                __builtin_amdgcn_sched_barrier(0);
                const bool samp = row >= MP; const int t = samp ? ((row - MP) & 7) : (row & 2047);
                if (t == 0) { if (samp) { const float* sc = ((const float*)pk->in[I_SCONV]) + (size_t)((row - MP) >> 3) * 2 * D + c0; p2a = *(const f32x4*)sc; p2b = *(const f32x4*)(sc + 4); p1a = *(const f32x4*)(sc + D); p1b = *(const f32x4*)(sc + D + 4); }
                              else { p1a = (f32x4){0.f, 0.f, 0.f, 0.f}; p1b = p1a; p2a = p1a; p2b = p1a; } }
                f32x4 xa, xb, ga, gb; unp(uw, xa, xb); unp(gw4, ga, gb);
                const f32x4 ya = ga * (w0a * p2a + w1a * p1a + w2a * xa), yb = gb * (w0b * p2b + w1b * p1b + w2b * xb);
                *(u32x4*)(K_BGb + (size_t)row * D + c0) = (u32x4){pk2(ya[0], ya[1]), pk2(ya[2], ya[3]), pk2(yb[0], yb[1]), pk2(yb[2], yb[3])};
                p2a = p1a; p2b = p1b; p1a = xa; p1b = xb;
            }
        }
    }
    xcd_barrier(bar);
    PHASE_BEGIN();

    { SchedPair S{(const char*)K_Qb, (const char*)K_Wa, (const char*)K_BGb, (const char*)K_Wc, MP / 256, D / 256, G, bx, (size_t)256 * D * 2};
      EpiG2 E{K_SAb, K_SBb, K_SAb};
      pg8::gemm_phase<EpiG2, SchedPair, true>(L, D, S, E); }
    xcd_barrier(bar);
    PHASE_BEGIN();

    { SchedPlain S{(const char*)K_SAb, (const char*)K_Wm, MP / 256, D / 256, G, bx, (size_t)256 * D * 2};
      EpiG3N E{((const float*)pk->in[I_XP]), ((const float*)pk->in[I_XS]), K_X1, K_H2, K_mod, ((const float*)pk->in[I_N2G]), RowStat{(float*)(ws + WS_SLOT3), (unsigned*)ws + CW_CNT3, (unsigned*)ws + CW_BAR + XB_TMO, (LAS float*)(L + TAB_OFF)}};
      pg8::gemm_phase<EpiG3N, SchedPlain, true>(L, D, S, E); }
    xcd_barrier(bar);
    PHASE_BEGIN();

    { SchedPlain S{(const char*)K_H2, (const char*)K_Wup, M / 256, NUP / 256, G, bx, (size_t)256 * D * 2};
      EpiG4F E{K_VLb, ((float*)pk->out), (float*)(ws + WS_SIDEL), (float*)(ws + WS_SIDEF), ((const float*)pk->in[I_FCW]), ((const float*)pk->in[I_SFFN]), (LAS float*)(L + XL_OFF)};
      pg8::gemm_phase<EpiG4F, SchedPlain, false>(L, D, S, E); }
    xcd_barrier(bar);
    PHASE_BEGIN();

    for (long Lt = bx; Lt < 256; Lt += G) { int pm_, pn_; pg8::tile_of((int)Lt, MP / 256, D / 256, pm_, pn_);
        if ((pm_ & 7) != 0) ffn_fixup(pm_, K_VLb, (const float*)(ws + WS_SIDEL), (const float*)(ws + WS_SIDEF), ((const float*)pk->in[I_FCW])); }
    asm volatile("s_waitcnt vmcnt(0)" ::: "memory"); __syncthreads();
    { SchedPlain Sd{(const char*)K_VLb, (const char*)K_Wdn, MP / 256, D / 256, G, bx, (size_t)256 * DFF * 2};
      EpiG5N<true> E{K_X1, K_OUT, K_mod, ((const float*)pk->in[I_FING]), RowStat{(float*)(ws + WS_SLOT5), (unsigned*)ws + CW_CNT5, (unsigned*)ws + CW_BAR + XB_TMO, (LAS float*)(L + TAB_OFF)}, (const unsigned*)ws + CW_BAR + XB_TMO};
      pg8::gemm_phase<EpiG5N<true>, SchedPlain, true>(L, DFF, Sd, E); }
}

extern "C" void kernel_launch(void* const* d_in, const int* in_sizes, int n_in, void* d_out, int out_size, void* d_ws, size_t ws_size, hipStream_t stream) {
    static int grid = 0;
    if (grid == 0) {
        int dev = 0, cus = 0, per_cu = 0;
        if (n_in != 22 || out_size != (int)O_END || ws_size < WS_END) { fprintf(stderr, "kernel_launch: unexpected shapes (n_in %d out %d ws %zu)\n", n_in, out_size, ws_size); grid = -1; return; }
        if (hipGetDevice(&dev) != hipSuccess || hipDeviceGetAttribute(&cus, hipDeviceAttributeMultiprocessorCount, dev) != hipSuccess) { grid = -1; return; }
        if (hipFuncSetAttribute((const void*)fwd_kernel, hipFuncAttributeMaxDynamicSharedMemorySize, LDS_BYTES) != hipSuccess) { grid = -1; return; }
        if (hipOccupancyMaxActiveBlocksPerMultiprocessor(&per_cu, (const void*)fwd_kernel, NWAVES * 64, LDS_BYTES) != hipSuccess || per_cu < 1) { fprintf(stderr, "occupancy query: %d\n", per_cu); grid = -1; return; }
        grid = cus;
    }
    if (grid < 0) return;
    (void)hipMemsetAsync(d_ws, 0, CTL_BYTES, stream);
    KP p{};
    for (int i = 0; i < 22; ++i) p.in[i] = (const float*)d_in[i];
    p.out = (float*)d_out; p.ws = (unsigned char*)d_ws;
    void* args[] = {&p};
    hipError_t e = hipLaunchCooperativeKernel((const void*)fwd_kernel, dim3(grid), dim3(NWAVES * 64), args, LDS_BYTES, stream);
    if (e != hipSuccess) fprintf(stderr, "cooperative launch failed: %s\n", hipGetErrorString(e));
}
```

```cpp
#include <hip/hip_runtime.h>
#include <hip/hip_cooperative_groups.h>
#include <cstdio>
#include <cstdint>

#define GAS __attribute__((address_space(1)))
#define LAS __attribute__((address_space(3)))
typedef unsigned short bf16_t;
typedef short bf16x8 __attribute__((ext_vector_type(8)));
typedef short s16x4 __attribute__((ext_vector_type(4)));
typedef float f32x2 __attribute__((ext_vector_type(2)));
typedef float f32x4 __attribute__((ext_vector_type(4)));
typedef float f32x16 __attribute__((ext_vector_type(16)));
typedef unsigned u32x2 __attribute__((ext_vector_type(2)));
typedef unsigned u32x4 __attribute__((ext_vector_type(4)));

constexpr int M = 17408, MP = 16384, D = 1024, NIN = 6656, DFF = 2816, NUP = 5632, NBATCH = 136;
constexpr int SEQ = 2048, DSEQ = 8, NBP = 8, NBS = 128, WIN = 128, KVW = 256;
constexpr float RMS_EPS = 1e-6f, LOG2E = 1.4426950408889634f;
constexpr float QSCALE = 0.125f * LOG2E;
constexpr size_t O_Y = 0, O_CONV_P = 17825792, O_K_P = 17842176, O_V_P = 18104320, O_FFN_P = 18366464,
                 O_CONV_S = 18411520, O_K_S = 18673664, O_V_S = 22867968, O_FFN_S = 27062272, O_END = 27783168;
constexpr size_t MiB = 1u << 20;
constexpr size_t WS_CTL = 0, WS_WUP = 1 * MiB, WS_WDN = 12 * MiB, WS_MOD = 17 * MiB + 512 * 1024, WS_WIN = 21 * MiB, WS_WC = 34 * MiB, WS_WA = 36 * MiB, WS_WM = 38 * MiB,
                 WS_U = 40 * MiB, WS_BG = 74 * MiB, WS_Q = 108 * MiB, WS_SA = 142 * MiB, WS_SB = 176 * MiB, WS_K = 210 * MiB, WS_V = 218 * MiB + 512 * 1024,
                 WS_VAL = 148 * MiB + 512 * 1024, WS_SIDEL = 242 * MiB + 512 * 1024, WS_SIDEF = 245 * MiB, WS_SLOT3 = 248 * MiB, WS_SLOT5 = 250 * MiB, WS_END = 256 * MiB;
static_assert(WS_V + (size_t)M * KVW * 2 <= WS_END && WS_VAL + (size_t)M * DFF * 2 <= WS_SIDEL && WS_SLOT5 + (size_t)M * 16 * 4 <= WS_END && WS_SIDEF + (size_t)68 * 4 * DFF * 4 <= WS_SLOT3, "ws map");
static_assert(WS_MOD + (size_t)NBATCH * 6 * D * 4 <= WS_WIN && WS_WDN + (size_t)D * DFF * 2 <= WS_MOD && WS_WUP + (size_t)NUP * D * 2 <= WS_WDN && WS_WIN + (size_t)NIN * D * 2 <= WS_WC, "ws map 2");
constexpr int CW_BAR = 4096, CW_MODCNT = 1024, CW_CNT3 = 8192, CW_CNT5 = 16384, CTL_BYTES = 131072;

constexpr int NWAVES = 8;
constexpr int LDS_BYTES = 147456;
constexpr int MISC_OFF = LDS_BYTES - 128;

struct KP { const float* in[22]; float* out; unsigned char* ws; };
enum { I_XP = 0, I_XS, I_CP, I_CS, I_SCONV, I_CK, I_CV, I_SFFN, I_N1G, I_N2G, I_WADA, I_BADA, I_WIN, I_CONVW, I_WCO, I_SINK, I_WAO, I_WMIX, I_WUP, I_FCW, I_WDN, I_FING };

__device__ __forceinline__ unsigned f2bf(float f) { unsigned u = __builtin_bit_cast(unsigned, f); return (u + 0x7fffu + ((u >> 16) & 1u)) >> 16; }
__device__ __forceinline__ unsigned pk2(float lo, float hi) { return f2bf(lo) | (f2bf(hi) << 16); }
#define NT_LD(p) __builtin_nontemporal_load(p)
#define NT_ST(v, p) __builtin_nontemporal_store((v), (p))
typedef __bf16 bf16x2_t __attribute__((ext_vector_type(2)));
__device__ __forceinline__ unsigned cvtpk_s(float lo, float hi) { f32x2 v = {lo, hi}; bf16x2_t b = __builtin_convertvector(v, bf16x2_t); return __builtin_bit_cast(unsigned, b); }
__device__ __forceinline__ float bflo(unsigned w) { return __builtin_bit_cast(float, w << 16); }
__device__ __forceinline__ float bfhi(unsigned w) { return __builtin_bit_cast(float, w & 0xffff0000u); }
__device__ __forceinline__ float wave_sum(float v) {
#pragma unroll
    for (int o = 1; o < 64; o <<= 1) v += __shfl_xor(v, o);
    return v;
}
__device__ __forceinline__ float sigmoidf_(float x) { return __builtin_amdgcn_rcpf(1.f + __builtin_amdgcn_exp2f(-x * LOG2E)); }
__device__ __forceinline__ f32x2 gelu_pk(f32x2 v) {
    const f32x2 av = __builtin_elementwise_abs(v), d = av * 0.2316418882f + 1.0f;
    f32x2 t; t.x = __builtin_amdgcn_rcpf(d.x); t.y = __builtin_amdgcn_rcpf(d.y);
    f32x2 q = t * 0.5307027145f + (-0.7265760135f); q = q * t + 0.7107068705f; q = q * t + (-0.142248368f); q = q * t + 0.127414796f; q = q * t;
    const f32x2 s = (v * v) * (-0.72134752044f);
    f32x2 e; e.x = __builtin_amdgcn_exp2f(s.x); e.y = __builtin_amdgcn_exp2f(s.y);
    const f32x2 m = v * (q * e), r = v - m;
    f32x2 o; o.x = v.x < 0.f ? m.x : r.x; o.y = v.y < 0.f ? m.y : r.y; return o;
}
__device__ __forceinline__ int row_batch(int row) { return row < MP ? (row >> 11) : NBP + ((row - MP) >> 3); }

#define XB_TMO      128
#define XB_XCNT(j)  (256  + 64 * (j))
#define XB_XSUB(j)  (1280 + 64 * (j))
#define XB_XGEN(j)  (2304 + 64 * (j))
#define XB_TOP      3328
#define XB_TOPGEN   3392
#define XCD_BAR_WORDS 3456
#define XB_SPIN_CAP (1u << 18)
__device__ __forceinline__ unsigned xb_ld(unsigned* p)              { return __hip_atomic_load(p, __ATOMIC_RELAXED, __HIP_MEMORY_SCOPE_AGENT); }
__device__ __forceinline__ unsigned xb_add(unsigned* p, unsigned v) { return __hip_atomic_fetch_add(p, v, __ATOMIC_RELAXED, __HIP_MEMORY_SCOPE_AGENT); }
__device__ __forceinline__ unsigned xb_xcc_id() { return (unsigned)__builtin_amdgcn_s_getreg((3 << 11) | 20) & 0xFu; }
#define XB_SPIN(cond, bar) do { unsigned _sp = 0; while (cond) { __builtin_amdgcn_s_sleep(1); \
    if ((++_sp & 255u) == 0u) { if (xb_ld(&(bar)[XB_TMO])) break; if (_sp > XB_SPIN_CAP) { atomicAdd(&(bar)[XB_TMO], 1u); break; } } } } while (0)
struct XcdBarrier { unsigned* bar; unsigned x; volatile LAS unsigned* st; };
__device__ __forceinline__ XcdBarrier xcd_barrier_post(unsigned* bar, volatile LAS unsigned* st) {
    XcdBarrier b; b.bar = bar; b.x = xb_xcc_id(); b.st = st;
    if (threadIdx.x == 0) (void)xb_add(&bar[XB_XCNT(b.x)], 1u);
    return b;
}
__device__ __forceinline__ void xcd_barrier_complete(unsigned* bar, unsigned x, unsigned& nloc, unsigned& nx) {
    const unsigned G = gridDim.x * gridDim.y * gridDim.z;
    unsigned sum, cnt, mine, sp = 0u;
    for (;;) {
        sum = 0u; cnt = 0u; mine = 0u;
#pragma unroll
        for (unsigned j = 0; j < 16; ++j) { const unsigned c = xb_ld(&bar[XB_XCNT(j)]); sum += c; cnt += (c > 0u) ? 1u : 0u; mine = (j == x) ? c : mine; }
        if (sum == G) break;
        __builtin_amdgcn_s_sleep(1);
        if ((++sp & 255u) == 0u) { if (xb_ld(&bar[XB_TMO])) break; if (sp > XB_SPIN_CAP) { atomicAdd(&bar[XB_TMO], 1u); break; } }
    }
    nloc = mine > 0u ? mine : 1u; nx = cnt > 0u ? cnt : 1u;
}
__device__ __forceinline__ void xcd_barrier(const XcdBarrier& b) {
    asm volatile("s_waitcnt vmcnt(0)" ::: "memory");
    __syncthreads();
    if (threadIdx.x == 0) {
        unsigned* bar = b.bar;
        __builtin_amdgcn_s_waitcnt(0);
        unsigned nloc = b.st[0], nx = b.st[1];
        if (nloc == 0u) { xcd_barrier_complete(bar, b.x, nloc, nx); b.st[0] = nloc; b.st[1] = nx; }
        const unsigned old = xb_add(&bar[XB_XSUB(b.x)], 1u);
        const unsigned gen = old / nloc;
        if (old + 1u == (gen + 1u) * nloc) {
            __builtin_amdgcn_fence(__ATOMIC_RELEASE, "agent");
            asm volatile("s_waitcnt vmcnt(0)" ::: "memory");
            const unsigned og = xb_add(&bar[XB_TOP], 1u);
            const unsigned tg = og / nx;
            if (og + 1u == (tg + 1u) * nx) xb_add(&bar[XB_TOPGEN], 1u);
            else XB_SPIN(xb_ld(&bar[XB_TOPGEN]) == tg, bar);
            __builtin_amdgcn_fence(__ATOMIC_ACQUIRE, "agent");
            xb_add(&bar[XB_XGEN(b.x)], 1u);
            asm volatile("s_waitcnt vmcnt(0)" ::: "memory");
        } else {
            XB_SPIN(xb_ld(&bar[XB_XGEN(b.x)]) == gen, bar);
            __builtin_amdgcn_fence(__ATOMIC_ACQUIRE, "agent");
            asm volatile("s_waitcnt vmcnt(0)" ::: "memory");
        }
    }
    __syncthreads();
}

#define MK_RSRC(p) __builtin_amdgcn_make_buffer_rsrc((void*)(p), 0, 0x7fffffff, 0x00020000)
namespace pg8 {
constexpr int BM = 256, BK = 64, HALF = 128, HTB = HALF * BK * 2, STAGE_BYTES = 8 * HTB, NXCD = 8, WGM = 4;
__host__ __device__ __forceinline__ int lds_byte(int r, int c) { const int st = (r >> 4) * 2 + (c >> 5), rr = r & 15, cc = c & 31, ob = rr * 64 + cc * 2; return st * 1024 + (ob ^ (((ob >> 9) & 1) << 5)); }
__host__ __device__ __forceinline__ void stage_rc(int b, int& R, int& C) { const int st = b / 1024, sb = b % 1024, swz = sb ^ (((sb >> 9) & 1) << 5); R = (st >> 1) * 16 + swz / 64; C = (st & 1) * 32 + (swz % 64) / 2; }
__host__ __device__ __forceinline__ int perm32(int rho) { const int n = rho >> 4, i = rho & 15; return 8 * (i >> 2) + 4 * n + (i & 3); }

struct Unit { int pm, pn, kind; __amdgpu_buffer_rsrc_t ra, rb; unsigned a, b, x; };

__device__ __forceinline__ void tile_of(int L, int nM, int nN, int& pm, int& pn) {
    const int nwg = nM * nN; int wgid = L;
    { const int q = nwg / NXCD, r = nwg % NXCD, xcd = wgid % NXCD, off = wgid / NXCD; wgid = (xcd < r ? xcd * (q + 1) : r * (q + 1) + (xcd - r) * q) + off; }
    const int nig = WGM * nN, gid = wgid / nig, fm = gid * WGM, gsz = (nM - fm) < WGM ? (nM - fm) : WGM;
    pm = fm + ((wgid % nig) % gsz); pn = (wgid % nig) / gsz;
}

constexpr int XS_OFF = 131072;
template <class Epi, class Sched, bool XS>
__device__ __forceinline__ void gemm_phase(LAS unsigned char* lds, const int K, const Sched& S, const Epi& E) {
    int tid = threadIdx.x; asm volatile("" : "+v"(tid));
    const int wid = __builtin_amdgcn_readfirstlane(tid >> 6), lane = tid & 63, wr = wid >> 2, wc = wid & 3, fr = lane & 15, fq = lane >> 4;
    const int nt = K / BK;
    unsigned voffA, voffB;
    { int R, C; stage_rc(tid * 16, R, C); const int Rb = (R & ~31) + perm32(R & 31); voffA = (unsigned)(R * K + C) * 2u; voffB = (unsigned)(Rb * K + C) * 2u; }
    const unsigned rstep = (unsigned)(64 * K * 2);
#define PG8_VOFFX() ({ int l_ = (int)(threadIdx.x & 63); asm volatile("" : "+v"(l_)); (unsigned)((2 * wid + (l_ >> 5)) * K) * 2u + (unsigned)(l_ & 31) * 4u; })
#define PG8_XOFF() ({ int l_ = (int)(threadIdx.x & 63); asm volatile("" : "+v"(l_)); XS_OFF + (l_ & 15) * 128 + (l_ >> 4) * 16; })
    const unsigned kstep = (unsigned)(BK * 2);
    const unsigned hstep = (unsigned)(HALF * K * 2);
    const unsigned ldsw = (unsigned)wid * 1024u;
    const int aoff = lds_byte(wr * 64 + fr, fq * 8), boff = lds_byte(wc * 32 + fr, fq * 8);
#define PG8_SA(b, h) (((b) * 2 + (h)) * HTB)
#define PG8_SB(b, h) ((4 + (b) * 2 + (h)) * HTB)
#define PG8_STAGE(bufoff, rsrc, soff, voff) do { _Pragma("unroll") for (int _i = 0; _i < 2; ++_i) \
        __builtin_amdgcn_raw_ptr_buffer_load_lds((rsrc), (LAS void*)(lds + (bufoff) + ldsw + _i * 8192), 16, (voff), (soff) + _i * rstep, 0, 0); } while (0)
#define PG8_STAGEX(b, rsrc, soff) do { if constexpr (XS) __builtin_amdgcn_raw_ptr_buffer_load_lds((rsrc), (LAS void*)(lds + XS_OFF + (b) * 2048 + wid * 256), 4, PG8_VOFFX(), (soff), 0, 0); } while (0)
#define PG8_LDA(dst, b, h) do { _Pragma("unroll") for (int m = 0; m < 4; ++m) _Pragma("unroll") for (int k = 0; k < 2; ++k) dst[m][k] = *(const LAS bf16x8*)(lds + PG8_SA(b, h) + aoff + m * 2048 + k * 1024); } while (0)
#define PG8_LDB(dst, b, h) do { _Pragma("unroll") for (int n = 0; n < 2; ++n) _Pragma("unroll") for (int k = 0; k < 2; ++k) dst[n][k] = *(const LAS bf16x8*)(lds + PG8_SB(b, h) + boff + n * 2048 + k * 1024); } while (0)
#define PG8_LDX(b) do { if constexpr (XS) { const int xo_ = PG8_XOFF(); Xf[0] = *(const LAS bf16x8*)(lds + xo_ + (b) * 2048); Xf[1] = *(const LAS bf16x8*)(lds + xo_ + (b) * 2048 + 64); } } while (0)
#define PG8_MMA(ai, bj, At, Bt) do { __builtin_amdgcn_s_setprio(1); _Pragma("unroll") for (int m = 0; m < 4; ++m) _Pragma("unroll") for (int n = 0; n < 2; ++n) _Pragma("unroll") for (int k = 0; k < 2; ++k) \
        acc[ai][bj][m][n] = __builtin_amdgcn_mfma_f32_16x16x32_bf16(Bt[n][k], At[m][k], acc[ai][bj][m][n], 0, 0, 0); __builtin_amdgcn_s_setprio(0); } while (0)
#define PG8_MMAX() do { if constexpr (XS) { if (wr == 0) { _Pragma("unroll") for (int n = 0; n < 2; ++n) _Pragma("unroll") for (int k = 0; k < 2; ++k) ax[n] = __builtin_amdgcn_mfma_f32_16x16x32_bf16(B0[n][k], Xf[k], ax[n], 0, 0, 0); } \
        else { _Pragma("unroll") for (int n = 0; n < 2; ++n) _Pragma("unroll") for (int k = 0; k < 2; ++k) ax[n] = __builtin_amdgcn_mfma_f32_16x16x32_bf16(B1[n][k], Xf[k], ax[n], 0, 0, 0); } } } while (0)
#define PG8_WAIT_V(n) asm volatile("s_waitcnt vmcnt(" #n ")" ::: "memory")
#define PG8_WAIT_VL() do { if constexpr (XS) PG8_WAIT_V(9); else PG8_WAIT_V(8); } while (0)
#define PG8_WAIT_L(n) asm volatile("s_waitcnt lgkmcnt(" #n ")" ::: "memory")
#define PG8_BAR __builtin_amdgcn_s_barrier()
#define PG8_SCHED __builtin_amdgcn_sched_barrier(0)
    Unit cur, nxt; int ui = 0;
    if (!S.next(0, cur)) return;
    f32x4 acc[2][2][4][2];
#pragma unroll
    for (int a = 0; a < 2; ++a)
#pragma unroll
        for (int b = 0; b < 2; ++b)
#pragma unroll
            for (int m = 0; m < 4; ++m)
#pragma unroll
                for (int n = 0; n < 2; ++n) acc[a][b][m][n] = (f32x4){0.f, 0.f, 0.f, 0.f};
    f32x4 ax[2] = {{0.f, 0.f, 0.f, 0.f}, {0.f, 0.f, 0.f, 0.f}};
    bf16x8 At[4][2], B0[2][2], B1[2][2], Xf[2];
    unsigned cA = cur.a, cB = cur.b, cX = cur.x; __amdgpu_buffer_rsrc_t rA = cur.ra, rB = cur.rb;
    PG8_STAGE(PG8_SB(0, 0), rB, cB, voffB); PG8_STAGE(PG8_SB(0, 1), rB, cB + hstep, voffB); PG8_STAGE(PG8_SA(0, 0), rA, cA, voffA); PG8_STAGEX(0, rA, cX); PG8_STAGE(PG8_SA(0, 1), rA, cA + hstep, voffA);
    if (wr == 1) PG8_BAR;
    PG8_WAIT_V(2); PG8_BAR;
    PG8_STAGEX(1, rA, cX + kstep); PG8_STAGE(PG8_SB(1, 0), rB, cB + kstep, voffB); PG8_STAGE(PG8_SA(1, 0), rA, cA + kstep, voffA); PG8_STAGE(PG8_SB(1, 1), rB, cB + hstep + kstep, voffB);
    if constexpr (XS) PG8_WAIT_V(7); else PG8_WAIT_V(6);
    PG8_BAR;
    for (;;) {
        const bool has_next = S.next(ui + 1, nxt);
        const unsigned nA = has_next ? nxt.a : cA, nB = has_next ? nxt.b : cB, nX = has_next ? nxt.x : cX;
        const __amdgpu_buffer_rsrc_t nrA = has_next ? nxt.ra : rA, nrB = has_next ? nxt.rb : rB;
        for (int t = 0; t < nt; t += 2) {
            const bool last = (t == nt - 2);
            const unsigned a1 = cA + (unsigned)(t + 1) * kstep;
            const unsigned a2 = last ? nA : cA + (unsigned)(t + 2) * kstep, b2 = last ? nB : cB + (unsigned)(t + 2) * kstep, x2 = last ? nX : cX + (unsigned)(t + 2) * kstep;
            const unsigned a3 = a2 + kstep, b3 = b2 + kstep, x3 = x2 + kstep;
            const __amdgpu_buffer_rsrc_t r2A = last ? nrA : rA, r2B = last ? nrB : rB;
            PG8_LDB(B0, 0, 0); PG8_LDB(B1, 0, 1); PG8_LDX(0); PG8_SCHED; PG8_LDA(At, 0, 0); PG8_STAGE(PG8_SA(1, 1), rA, a1 + hstep, voffA);
            PG8_WAIT_VL(); PG8_WAIT_L(0); PG8_BAR; PG8_MMA(0, 0, At, B0); PG8_MMA(0, 1, At, B1); PG8_MMAX(); PG8_BAR; PG8_SCHED;
            PG8_LDA(At, 0, 1); PG8_STAGE(PG8_SB(0, 0), r2B, b2, voffB); PG8_STAGE(PG8_SB(0, 1), r2B, b2 + hstep, voffB); PG8_STAGE(PG8_SA(0, 0), r2A, a2, voffA); PG8_STAGEX(0, r2A, x2);
            PG8_WAIT_VL(); PG8_WAIT_L(0); PG8_BAR; PG8_MMA(1, 0, At, B0); PG8_MMA(1, 1, At, B1); PG8_BAR; PG8_SCHED;
            PG8_LDB(B0, 1, 0); PG8_LDB(B1, 1, 1); PG8_LDX(1); PG8_SCHED; PG8_LDA(At, 1, 0); PG8_STAGE(PG8_SA(0, 1), r2A, a2 + hstep, voffA);
            PG8_WAIT_VL(); PG8_WAIT_L(0); PG8_BAR; PG8_MMA(0, 0, At, B0); PG8_MMA(0, 1, At, B1); PG8_MMAX(); PG8_BAR; PG8_SCHED;
            PG8_LDA(At, 1, 1); PG8_STAGE(PG8_SB(1, 0), r2B, b3, voffB); PG8_STAGE(PG8_SB(1, 1), r2B, b3 + hstep, voffB); PG8_STAGE(PG8_SA(1, 0), r2A, a3, voffA); PG8_STAGEX(1, r2A, x3);
            PG8_WAIT_VL(); PG8_WAIT_L(0); PG8_BAR; PG8_MMA(1, 0, At, B0); PG8_MMA(1, 1, At, B1); PG8_BAR; PG8_SCHED;
        }
        if (wr == 0) PG8_BAR;
        const bool keep = E(acc, ax, cur, wr, wc, fr, fq);
        if (!has_next) break;
        if (!keep) {
#pragma unroll
            for (int a = 0; a < 2; ++a)
#pragma unroll
                for (int b = 0; b < 2; ++b)
#pragma unroll
                    for (int m = 0; m < 4; ++m)
#pragma unroll
                        for (int n = 0; n < 2; ++n) acc[a][b][m][n] = (f32x4){0.f, 0.f, 0.f, 0.f};
            ax[0] = (f32x4){0.f, 0.f, 0.f, 0.f}; ax[1] = ax[0];
        }
        cur = nxt; cA = nA; cB = nB; cX = nX; rA = nrA; rB = nrB; ++ui;
        if (wr == 1) PG8_BAR;
    }
    PG8_WAIT_V(0);
    PG8_BAR;
#undef PG8_SA
#undef PG8_SB
#undef PG8_STAGE
#undef PG8_STAGEX
#undef PG8_VOFFX
#undef PG8_XOFF
#undef PG8_LDA
#undef PG8_LDB
#undef PG8_LDX
#undef PG8_MMA
#undef PG8_MMAX
#undef PG8_WAIT_V
#undef PG8_WAIT_VL
#undef PG8_WAIT_L
#undef PG8_BAR
#undef PG8_SCHED
}
}
using pg8::Unit;
typedef f32x4 Acc[2][2][4][2];

__device__ __forceinline__ void unpack8(const u32x4 w, f32x4& a, f32x4& b) { a = (f32x4){bflo(w.x), bfhi(w.x), bflo(w.y), bfhi(w.y)}; b = (f32x4){bflo(w.z), bfhi(w.z), bflo(w.w), bfhi(w.w)}; }
struct SchedPlain {
    const char* A; const char* Bt; int nM, nN, G, c; size_t tstep;
    __device__ __forceinline__ bool next(int i, Unit& u) const {
        const long L = (long)i * G + c; if (L >= (long)nM * nN) return false;
        pg8::tile_of((int)L, nM, nN, u.pm, u.pn); u.kind = 0; u.ra = MK_RSRC(A); u.rb = MK_RSRC(Bt);
        u.a = (unsigned)((size_t)u.pm * tstep); u.b = (unsigned)((size_t)u.pn * tstep); u.x = (unsigned)((size_t)(MP + 16 * u.pm) * (tstep / 256)); return true;
    }
};
struct SchedPair {
    const char* A0; const char* B0; const char* A1; const char* B1; int nM, nN, G, c; size_t tstep;
    __device__ __forceinline__ bool next(int i, Unit& u) const {
        const long L = (long)(i >> 1) * G + c; if (L >= (long)nM * nN) return false;
        pg8::tile_of((int)L, nM, nN, u.pm, u.pn); u.kind = i & 1; u.ra = MK_RSRC((i & 1) ? A1 : A0); u.rb = MK_RSRC((i & 1) ? B1 : B0);
        u.a = (unsigned)((size_t)u.pm * tstep); u.b = (unsigned)((size_t)u.pn * tstep); u.x = (unsigned)((size_t)(MP + 16 * u.pm) * (tstep / 256)); return true;
    }
};

#define EPI_ROWS(ai, m) (u.pm * 256 + (ai) * 128 + wr * 64 + (m) * 16 + fr)
__device__ __forceinline__ u32x4 pack8(const f32x4 v0, const f32x4 v1) { u32x4 w; w.x = cvtpk_s(v0[0], v0[1]); w.y = cvtpk_s(v0[2], v0[3]); w.z = cvtpk_s(v1[0], v1[1]); w.w = cvtpk_s(v1[2], v1[3]); return w; }

struct EpiG1 {
    bf16_t *U, *BG, *Q, *KB, *VB, *SA, *SB; float* out;
    __device__ __forceinline__ bool operator()(Acc& acc, f32x4 (&ax)[2], const Unit& u, int wr, int wc, int fr, int fq) const {
        const int pn = u.pn, cw = wc * 32 + 8 * fq; const bool samp = u.pm >= 64;
        if (pn < 8) {
#pragma unroll
            for (int ai = 0; ai < 2; ++ai)
#pragma unroll
                for (int m = 0; m < 4; ++m) { const int row = EPI_ROWS(ai, m); const int col = pn * 128 + cw;
                    const f32x4 v0 = acc[ai][0][m][0] * acc[ai][1][m][0], v1 = acc[ai][0][m][1] * acc[ai][1][m][1];
                    *(u32x4*)(U + (size_t)row * D + col) = pack8(v0, v1);
                    float* so = nullptr;
                    if (!samp) { const int t = row & 2047; if (t >= 2046) so = out + O_CONV_P + (size_t)((row >> 11) * 2 + (t - 2046)) * D + col; }
                    else { const int rs = row - MP, t = rs & 7; if (t >= 6) so = out + O_CONV_S + (size_t)((rs >> 3) * 2 + (t - 6)) * D + col; }
                    if (so) { NT_ST(v0, (f32x4*)so); NT_ST(v1, (f32x4*)(so + 4)); } }
        } else if (pn < 16) {
            bf16_t* dst = pn < 12 ? BG : Q; const float sc = pn < 12 ? 1.f : QSCALE; const int c0 = ((pn - 8) & 3) * 256 + cw;
#pragma unroll
            for (int ai = 0; ai < 2; ++ai)
#pragma unroll
                for (int m = 0; m < 4; ++m) { const int row = EPI_ROWS(ai, m);
#pragma unroll
                    for (int bj = 0; bj < 2; ++bj) *(u32x4*)(dst + (size_t)row * D + c0 + bj * 128) = pack8(acc[ai][bj][m][0] * sc, acc[ai][bj][m][1] * sc); }
        } else if (pn < 18) {
            bf16_t* dst = pn == 16 ? KB : VB; float* wo = out + (pn == 16 ? (samp ? O_K_S : O_K_P) : (samp ? O_V_S : O_V_P));
#pragma unroll
            for (int ai = 0; ai < 2; ++ai)
#pragma unroll
                for (int m = 0; m < 4; ++m) { const int row = EPI_ROWS(ai, m);
                    long wrow = -1;
                    if (!samp) { const int t = row & 2047; if (t >= SEQ - WIN) wrow = (long)(row >> 11) * WIN + (t - (SEQ - WIN)); }
                    else { const int rs = row - MP; wrow = (long)(rs >> 3) * WIN + (WIN - DSEQ) + (rs & 7); }
#pragma unroll
                    for (int bj = 0; bj < 2; ++bj) { const int col = cw + bj * 128;
                        *(u32x4*)(dst + (size_t)row * KVW + col) = pack8(acc[ai][bj][m][0], acc[ai][bj][m][1]);
                        if (wrow >= 0) { float* o = wo + (size_t)wrow * KVW + col; NT_ST(acc[ai][bj][m][0], (f32x4*)o); NT_ST(acc[ai][bj][m][1], (f32x4*)(o + 4)); } } }
        } else {
            const int col = (pn - 18) * 128 + cw;
#pragma unroll
            for (int ai = 0; ai < 2; ++ai)
#pragma unroll
                for (int m = 0; m < 4; ++m) { const int row = EPI_ROWS(ai, m);
                    { f32x4 a0, a1, r0, r1;
#pragma unroll
                      for (int j = 0; j < 4; ++j) { const float ea0 = 1.f + __builtin_amdgcn_exp2f(-acc[ai][0][m][0][j] * LOG2E), ea1 = 1.f + __builtin_amdgcn_exp2f(-acc[ai][0][m][1][j] * LOG2E);
                          a0[j] = __builtin_amdgcn_rcpf(ea0); a1[j] = __builtin_amdgcn_rcpf(ea1);
                          r0[j] = ea0 * sigmoidf_(acc[ai][1][m][0][j]); r1[j] = ea1 * sigmoidf_(acc[ai][1][m][1][j]); }
                      *(u32x4*)(SA + (size_t)row * D + col) = pack8(a0, a1); *(u32x4*)(SB + (size_t)row * D + col) = pack8(r0, r1); } }
        }
        return false;
    }
};
struct EpiG2 {
    bf16_t *SA; const bf16_t *SB; bf16_t* MIX;
    __device__ __forceinline__ void elem(int row, int col, f32x4& v0, f32x4& v1, int step) const {
        const size_t off = (size_t)row * D + col;
        const u32x4 a = *(const u32x4*)((step == 0 ? SB : SA) + off);
        const f32x4 s0 = {bflo(a.x), bfhi(a.x), bflo(a.y), bfhi(a.y)}, s1 = {bflo(a.z), bfhi(a.z), bflo(a.w), bfhi(a.w)};
        if (step == 0) { v0 = v0 * s0; v1 = v1 * s1; }
        else *(u32x4*)(MIX + off) = pack8(v0 * s0, v1 * s1);
    }
    __device__ __forceinline__ bool operator()(Acc& acc, f32x4 (&ax)[2], const Unit& u, int wr, int wc, int fr, int fq) const {
        const int cw = u.pn * 256 + wc * 32 + 8 * fq;
#pragma unroll
        for (int ai = 0; ai < 2; ++ai)
#pragma unroll
            for (int m = 0; m < 4; ++m)
#pragma unroll
                for (int bj = 0; bj < 2; ++bj) elem(EPI_ROWS(ai, m), cw + bj * 128, acc[ai][bj][m][0], acc[ai][bj][m][1], u.kind);
        elem(MP + 16 * u.pm + fr, cw + wr * 128, ax[0], ax[1], u.kind);
        return u.kind == 0;
    }
};
constexpr int TAB_OFF = 136192;
struct RowStat { float* slots; unsigned* cnt; unsigned* tmo; LAS float* tab; };
__device__ __forceinline__ void rowstat_wait(const RowStat& st, int cidx, unsigned want) {
    unsigned* c = st.cnt + 64 * cidx; unsigned sp = 0;
    while ((unsigned)__builtin_amdgcn_readfirstlane(xb_ld(c)) < want) { __builtin_amdgcn_s_sleep(2);
        if ((++sp & 255u) == 0u) { if (xb_ld(st.tmo)) break; if (sp > XB_SPIN_CAP) { if ((threadIdx.x & 63) == 0) atomicAdd(st.tmo, 1u); break; } } }
    __builtin_amdgcn_fence(__ATOMIC_ACQUIRE, "agent");
}
#define RS_BAR() do { asm volatile("s_waitcnt vmcnt(0) lgkmcnt(0)" ::: "memory"); __builtin_amdgcn_s_barrier(); asm volatile("" ::: "memory"); } while (0)
__device__ __forceinline__ void rowstat_big(const RowStat& st, const Acc& v, const f32x4 (&ax)[2], const Unit& u, int wr, int wc, int fr, int fq) {
    const int lane = threadIdx.x & 63, wid = __builtin_amdgcn_readfirstlane(threadIdx.x >> 6);
    LAS float* P = st.tab; LAS float* S = st.tab + 1024; LAS float* PX = st.tab + 1312;
#pragma unroll
    for (int ai = 0; ai < 2; ++ai)
#pragma unroll
        for (int m = 0; m < 4; ++m) { float q = 0.f;
#pragma unroll
            for (int bj = 0; bj < 2; ++bj)
#pragma unroll
                for (int n = 0; n < 2; ++n) { const f32x4 x = v[ai][bj][m][n]; q += (x[0] * x[0] + x[1] * x[1]) + (x[2] * x[2] + x[3] * x[3]); }
            q += __shfl_xor(q, 16); q += __shfl_xor(q, 32);
            if (fq == 0) P[(ai * 128 + wr * 64 + m * 16 + fr) * 4 + wc] = q; }
    { float q = ((ax[0][0] * ax[0][0] + ax[0][1] * ax[0][1]) + (ax[0][2] * ax[0][2] + ax[0][3] * ax[0][3])) + ((ax[1][0] * ax[1][0] + ax[1][1] * ax[1][1]) + (ax[1][2] * ax[1][2] + ax[1][3] * ax[1][3]));
      q += __shfl_xor(q, 16); q += __shfl_xor(q, 32);
      if (fq == 0) PX[fr * 8 + wr * 4 + wc] = q; }
    RS_BAR();
    const int row = wid * 32 + (lane & 31);
    float* myslots = st.slots + (size_t)(u.pm * 4 + u.pn) * 272;
    if (lane < 32) { const f32x4 q = *(const LAS f32x4*)(P + row * 4);
        __hip_atomic_store(myslots + row, (q[0] + q[1]) + (q[2] + q[3]), __ATOMIC_RELAXED, __HIP_MEMORY_SCOPE_AGENT); }
    if (wid == 4 && lane < 16) { const f32x4 q0 = *(const LAS f32x4*)(PX + lane * 8), q1 = *(const LAS f32x4*)(PX + lane * 8 + 4);
        __hip_atomic_store(myslots + 256 + lane, ((q0[0] + q0[1]) + (q0[2] + q0[3])) + ((q1[0] + q1[1]) + (q1[2] + q1[3])), __ATOMIC_RELAXED, __HIP_MEMORY_SCOPE_AGENT); }
    asm volatile("s_waitcnt vmcnt(0)" ::: "memory");
    if (lane == 0) (void)xb_add(st.cnt + 64 * u.pm, 1u);
    if (wid == 0) rowstat_wait(st, u.pm, 32u);
    RS_BAR();
    const float* psl = st.slots + (size_t)(u.pm * 4) * 272;
    if (lane < 32) { float t = 0.f;
#pragma unroll
        for (int k = 0; k < 4; ++k) t += __hip_atomic_load(psl + k * 272 + row, __ATOMIC_RELAXED, __HIP_MEMORY_SCOPE_AGENT);
        S[row] = 1.0f / sqrtf(t * (1.f / D) + RMS_EPS); }
    if (wid == 4 && lane < 16) { float t = 0.f;
#pragma unroll
        for (int k = 0; k < 4; ++k) t += __hip_atomic_load(psl + k * 272 + 256 + lane, __ATOMIC_RELAXED, __HIP_MEMORY_SCOPE_AGENT);
        S[256 + lane] = 1.0f / sqrtf(t * (1.f / D) + RMS_EPS); }
    RS_BAR();
}
struct EpiG3N {
    const float* xp; const float* xs; bf16_t* X1; bf16_t* H2; const float* mod; const float* n2g; RowStat st;
    __device__ __forceinline__ void h2_store(int row, int col, const float* md, float rstd, const f32x4& v0, const f32x4& v1) const {
        const f32x4 g0 = *(const f32x4*)(n2g + col), g1 = *(const f32x4*)(n2g + col + 4), c0 = *(const f32x4*)(md + 4 * D + col), c1 = *(const f32x4*)(md + 4 * D + col + 4),
                    h0 = *(const f32x4*)(md + 3 * D + col), h1 = *(const f32x4*)(md + 3 * D + col + 4);
        *(u32x4*)(H2 + (size_t)row * D + col) = pack8(v0 * rstd * g0 * (c0 + 1.0f) + h0, v1 * rstd * g1 * (c1 + 1.0f) + h1);
    }
    __device__ __forceinline__ bool operator()(Acc& acc, f32x4 (&ax)[2], const Unit& u, int wr, int wc, int fr, int fq) const {
        const int cw = u.pn * 256 + wc * 32 + 8 * fq; const float* md = mod + (size_t)(u.pm >> 3) * (6 * D);
        {
            f32x4 gg[2][2];
#pragma unroll
            for (int bj = 0; bj < 2; ++bj) { gg[bj][0] = *(const f32x4*)(md + 2 * D + cw + bj * 128); gg[bj][1] = *(const f32x4*)(md + 2 * D + cw + bj * 128 + 4); }
#pragma unroll
            for (int ai = 0; ai < 2; ++ai)
#pragma unroll
                for (int m = 0; m < 4; ++m) { const int row = EPI_ROWS(ai, m);
#pragma unroll
                    for (int bj = 0; bj < 2; ++bj) { const float* src = xp + (size_t)row * D + cw + bj * 128;
                        const f32x4 x0 = *(const f32x4*)src, x1 = *(const f32x4*)(src + 4);
                        acc[ai][bj][m][0] = x0 + gg[bj][0] * acc[ai][bj][m][0]; acc[ai][bj][m][1] = x1 + gg[bj][1] * acc[ai][bj][m][1]; }
                    asm volatile("" : "+v"(acc[ai][0][m][0]), "+v"(acc[ai][0][m][1]), "+v"(acc[ai][1][m][0]), "+v"(acc[ai][1][m][1]));
                    if (m & 1) asm volatile("" ::: "memory"); }
        }
        const int xrow = MP + 16 * u.pm + fr, xcol = cw + wr * 128; const float* xmd = mod + (size_t)row_batch(xrow) * (6 * D);
        { const float* src = xs + (size_t)(xrow - MP) * D + xcol;
          ax[0] = *(const f32x4*)src + *(const f32x4*)(xmd + 2 * D + xcol) * ax[0]; ax[1] = *(const f32x4*)(src + 4) + *(const f32x4*)(xmd + 2 * D + xcol + 4) * ax[1]; }
        rowstat_big(st, acc, ax, u, wr, wc, fr, fq);
        const LAS float* S = st.tab + 1024;
        { *(u32x4*)(X1 + (size_t)xrow * D + xcol) = pack8(ax[0], ax[1]); h2_store(xrow, xcol, xmd, S[256 + fr], ax[0], ax[1]); }
        f32x4 sc[2][2], sh[2][2];
#pragma unroll
        for (int bj = 0; bj < 2; ++bj)
#pragma unroll
            for (int n = 0; n < 2; ++n) { const int col = cw + bj * 128 + 4 * n;
                sc[bj][n] = *(const f32x4*)(n2g + col) * (*(const f32x4*)(md + 4 * D + col) + 1.0f); sh[bj][n] = *(const f32x4*)(md + 3 * D + col); }
#pragma unroll
        for (int ai = 0; ai < 2; ++ai)
#pragma unroll
            for (int m = 0; m < 4; ++m) { const int row = EPI_ROWS(ai, m); const float rstd = S[ai * 128 + wr * 64 + m * 16 + fr];
#pragma unroll
                for (int bj = 0; bj < 2; ++bj) { *(u32x4*)(X1 + (size_t)row * D + cw + bj * 128) = pack8(acc[ai][bj][m][0], acc[ai][bj][m][1]);
                    *(u32x4*)(H2 + (size_t)row * D + cw + bj * 128) = pack8(acc[ai][bj][m][0] * rstd * sc[bj][0] + sh[bj][0], acc[ai][bj][m][1] * rstd * sc[bj][1] + sh[bj][1]); } }
        return false;
    }
};
template <bool XS> struct EpiG5N {
    const bf16_t* X1; float* OUT; const float* mod; const float* fg; RowStat st; const unsigned* btmo;
    __device__ __forceinline__ bool operator()(Acc& acc, f32x4 (&ax)[2], const Unit& u, int wr, int wc, int fr, int fq) const {
        const int cw = u.pn * 256 + wc * 32 + 8 * fq; const float* md = mod + (size_t)(u.pm >> 3) * (6 * D) + 5 * D;
        {   f32x4 gg[2][2];
#pragma unroll
            for (int bj = 0; bj < 2; ++bj) { gg[bj][0] = *(const f32x4*)(md + cw + bj * 128); gg[bj][1] = *(const f32x4*)(md + cw + bj * 128 + 4); }
#pragma unroll
            for (int ai = 0; ai < 2; ++ai)
#pragma unroll
                for (int m = 0; m < 4; ++m) { const int row = EPI_ROWS(ai, m);
#pragma unroll
                    for (int bj = 0; bj < 2; ++bj) { f32x4 x0, x1; unpack8(*(const u32x4*)(X1 + (size_t)row * D + cw + bj * 128), x0, x1);
                        acc[ai][bj][m][0] = x0 + gg[bj][0] * acc[ai][bj][m][0]; acc[ai][bj][m][1] = x1 + gg[bj][1] * acc[ai][bj][m][1]; }
                    asm volatile("" : "+v"(acc[ai][0][m][0]), "+v"(acc[ai][0][m][1]), "+v"(acc[ai][1][m][0]), "+v"(acc[ai][1][m][1]));
                    if (m & 1) asm volatile("" ::: "memory"); }
        }
        const int xrow = MP + 16 * u.pm + fr, xcol = cw + wr * 128; float* xo = OUT + (size_t)xrow * D + xcol;
        if constexpr (XS) { const float* xg = mod + (size_t)row_batch(xrow) * (6 * D) + 5 * D + xcol; f32x4 x0, x1; unpack8(*(const u32x4*)(X1 + (size_t)xrow * D + xcol), x0, x1);
          ax[0] = x0 + *(const f32x4*)xg * ax[0]; ax[1] = x1 + *(const f32x4*)(xg + 4) * ax[1]; }
        rowstat_big(st, acc, ax, u, wr, wc, fr, fq);
        const LAS float* S = st.tab + 1024; const float poison = (xb_ld((unsigned*)btmo) | xb_ld(st.tmo)) ? __builtin_nanf("") : 1.0f;
        f32x4 fgv[2][2];
#pragma unroll
        for (int bj = 0; bj < 2; ++bj) { fgv[bj][0] = *(const f32x4*)(fg + cw + bj * 128); fgv[bj][1] = *(const f32x4*)(fg + cw + bj * 128 + 4); }
        if constexpr (XS) { const float rx = S[256 + fr] * poison; *(f32x4*)xo = ax[0] * rx * (wr ? fgv[1][0] : fgv[0][0]); *(f32x4*)(xo + 4) = ax[1] * rx * (wr ? fgv[1][1] : fgv[0][1]); }
#pragma unroll
        for (int ai = 0; ai < 2; ++ai)
#pragma unroll
            for (int m = 0; m < 4; ++m) { const int row = EPI_ROWS(ai, m); const float rstd = S[ai * 128 + wr * 64 + m * 16 + fr] * poison;
#pragma unroll
                for (int bj = 0; bj < 2; ++bj) { float* o = OUT + (size_t)row * D + cw + bj * 128;
                    *(f32x4*)o = acc[ai][bj][m][0] * rstd * fgv[bj][0]; *(f32x4*)(o + 4) = acc[ai][bj][m][1] * rstd * fgv[bj][1]; } }
        return false;
    }
};
#define DPP_F(old, src, ctrl) __builtin_bit_cast(float, __builtin_amdgcn_update_dpp(__builtin_bit_cast(int, (float)(old)), __builtin_bit_cast(int, (float)(src)), (ctrl), 0xf, 0xf, false))
#define DPP_ROT(src, ctrl) __builtin_bit_cast(float, __builtin_amdgcn_mov_dpp(__builtin_bit_cast(int, (float)(src)), (ctrl), 0xf, 0xf, true))
constexpr int XL_OFF = 131072;
struct EpiG4F {
    bf16_t* GB; float* out; float* side_last; float* side_first; const float* fcw; const float* sffn; LAS float* xl;
    __device__ __forceinline__ bool operator()(Acc& acc, f32x4 (&ax)[2], const Unit& u, int wr, int wc, int fr, int fq) const {
        const int col = u.pn * 128 + wc * 32 + 8 * fq; const bool samp = u.pm >= 64;
        if (fr >= 14) {
#pragma unroll
            for (int ai = 0; ai < 2; ++ai)
#pragma unroll
                for (int n = 0; n < 2; ++n) *(LAS f32x4*)(xl + (((wr * 4 + wc) * 2 + ai) * 2 + (fr - 14)) * 32 + fq * 8 + n * 4) = acc[ai][0][3][n];
            if (wr == 1) { float* sl = side_last + ((size_t)u.pm * 2 + (fr - 14)) * DFF + col; *(f32x4*)sl = acc[1][0][3][0]; *(f32x4*)(sl + 4) = acc[1][0][3][1]; }
        }
        if (wr == 0 && fr < 2) { float* sf = side_first + ((size_t)u.pm * 2 + fr) * 2 * DFF + col;
            *(f32x4*)sf = acc[0][0][0][0]; *(f32x4*)(sf + 4) = acc[0][0][0][1]; *(f32x4*)(sf + DFF) = acc[0][1][0][0]; *(f32x4*)(sf + DFF + 4) = acc[0][1][0][1]; }
        asm volatile("s_waitcnt lgkmcnt(0)" ::: "memory"); __builtin_amdgcn_s_barrier(); asm volatile("" ::: "memory");
        const f32x4 w0a = *(const f32x4*)(fcw + col), w0b = *(const f32x4*)(fcw + col + 4), w1a = *(const f32x4*)(fcw + DFF + col), w1b = *(const f32x4*)(fcw + DFF + col + 4),
                    w2a = *(const f32x4*)(fcw + 2 * DFF + col), w2b = *(const f32x4*)(fcw + 2 * DFF + col + 4);
        f32x4 ror1p[2], ror2p[2];
#pragma unroll
        for (int ai = 0; ai < 2; ++ai)
#pragma unroll
            for (int m = 0; m < 4; ++m) { const int row = EPI_ROWS(ai, m);
                { bool st_ = false; size_t so_ = 0;
                  if (!samp) { const int t = row & 2047; if (t >= 2046) { st_ = true; so_ = O_FFN_P + (size_t)((row >> 11) * 2 + (t - 2046)) * DFF + col; } }
                  else { const int rs = row - MP, t = rs & 7; if (t >= 6) { st_ = true; so_ = O_FFN_S + (size_t)((rs >> 3) * 2 + (t - 6)) * DFF + col; } }
                  if (st_) { NT_ST(acc[ai][0][m][0], (f32x4*)(out + so_)); NT_ST(acc[ai][0][m][1], (f32x4*)(out + so_ + 4)); } }
                if (m == 0) {
                    f32x4 pv[2];
                    if (wr == 1 || ai == 1) { const LAS float* src = xl + ((((wr == 1 ? 0 : 1) * 4 + wc) * 2 + (wr == 1 ? ai : 0)) * 2 + (fr & 1)) * 32 + fq * 8;
                        pv[0] = *(const LAS f32x4*)src; pv[1] = *(const LAS f32x4*)(src + 4); }
                    else { pv[0] = (f32x4){0.f, 0.f, 0.f, 0.f}; pv[1] = pv[0]; }
#pragma unroll
                    for (int n = 0; n < 2; ++n)
#pragma unroll
                        for (int e = 0; e < 4; ++e) { ror1p[n][e] = DPP_ROT(pv[n][e], 0x121); ror2p[n][e] = DPP_ROT(pv[n][e], 0x122); }
                }
                f32x4 p1[2], p2[2];
#pragma unroll
                for (int n = 0; n < 2; ++n)
#pragma unroll
                    for (int e = 0; e < 4; ++e) { const float x = acc[ai][0][m][n][e];
                        const float r1 = DPP_ROT(x, 0x121), r2 = DPP_ROT(x, 0x122);
                        p1[n][e] = fr == 0 ? ror1p[n][e] : r1; p2[n][e] = fr < 2 ? ror2p[n][e] : r2;
                        ror1p[n][e] = r1; ror2p[n][e] = r2; }
                if (samp) { const int rs = row - MP, t = rs & 7;
                    if (t < 2) { const float* h = sffn + (size_t)(rs >> 3) * 2 * DFF + col;
                        const f32x4 h1a = *(const f32x4*)(h + DFF), h1b = *(const f32x4*)(h + DFF + 4);
                        if (t == 0) { p2[0] = *(const f32x4*)h; p2[1] = *(const f32x4*)(h + 4); p1[0] = h1a; p1[1] = h1b; } else { p2[0] = h1a; p2[1] = h1b; } } }
                const f32x4 c0 = w0a * p2[0] + w1a * p1[0] + w2a * acc[ai][0][m][0], c1 = w0b * p2[1] + w1b * p1[1] + w2b * acc[ai][0][m][1];
                const f32x2 g0 = gelu_pk((f32x2){c0[0], c0[1]}), g1 = gelu_pk((f32x2){c0[2], c0[3]}), g2 = gelu_pk((f32x2){c1[0], c1[1]}), g3 = gelu_pk((f32x2){c1[2], c1[3]});
                const f32x4 y0 = (f32x4){g0.x, g0.y, g1.x, g1.y} * acc[ai][1][m][0], y1 = (f32x4){g2.x, g2.y, g3.x, g3.y} * acc[ai][1][m][1];
                *(u32x4*)(GB + (size_t)row * DFF + col) = pack8(y0, y1);
                asm volatile("" ::: "memory"); }
        return false;
    }
};
__device__ __forceinline__ void ffn_fixup(int pm, bf16_t* GB, const float* side_last, const float* side_first, const float* fcw) {
    for (int e = threadIdx.x; e < 2 * DFF; e += 512) { const int r = e / DFF, j = e % DFF;
        const float* sf = side_first + (size_t)pm * 4 * DFF; const float* sl = side_last + (size_t)(pm - 1) * 2 * DFF;
        const float a0 = sf[(size_t)r * 2 * DFF + j], v = sf[(size_t)r * 2 * DFF + DFF + j];
        const float am1 = r == 0 ? sl[DFF + j] : sf[j], am2 = r == 0 ? sl[j] : sl[DFF + j];
        const f32x2 gl = gelu_pk((f32x2){fcw[j] * am2 + fcw[DFF + j] * am1 + fcw[2 * DFF + j] * a0, 0.f});
        GB[(size_t)(pm * 256 + r) * DFF + j] = (bf16_t)f2bf(gl.x * v); }
}

__device__ __forceinline__ int dst_row(int map, int n) {
    if (map == 1) {
        if (n < 1024) return 2048 + n;
        if (n < 2048) return 256 * ((n - 1024) >> 7) + (n & 127);
        if (n < 3072) return 256 * ((n - 2048) >> 7) + 128 + (n & 127);
        if (n < 4608) return n;
        if (n < 5632) return 4608 + 256 * ((n - 4608) >> 7) + (n & 127);
        return 4608 + 256 * ((n - 5632) >> 7) + 128 + (n & 127);
    }
    if (map == 2) {
        if (n < DFF) return 256 * (n >> 7) + (n & 127);
        const int mm = n - DFF; return 256 * (mm >> 7) + 128 + (mm & 127);
    }
    return n;
}
struct TItem { const float* W; bf16_t* WT; int K, N, map, item; };
__device__ __forceinline__ void titem_load(const TItem& t, int lane, float (&tv)[32]) {
    const int nblk = t.N / 32, kb = t.item / nblk, nb = t.item % nblk, k0 = 64 * kb, n0 = 32 * nb;
#pragma unroll
    for (int i = 0; i < 32; ++i) { const int kk = 2 * i + (lane >> 5); tv[i] = __builtin_nontemporal_load(t.W + (size_t)(k0 + kk) * t.N + n0 + (lane & 31)); }
}
__device__ __forceinline__ void titem_finish(const TItem& t, int lane, const float (&tv)[32], LAS float* scr) {
    const int nblk = t.N / 32, kb = t.item / nblk, nb = t.item % nblk, k0 = 64 * kb, n0 = 32 * nb;
#pragma unroll
    for (int i = 0; i < 32; ++i) { const int kk = 2 * i + (lane >> 5); scr[kk * 33 + (lane & 31)] = tv[i]; }
    asm volatile("s_waitcnt lgkmcnt(0)" ::: "memory");
    const int c = lane & 7, r0 = dst_row(t.map, n0);
#pragma unroll
    for (int j = 0; j < 4; ++j) { const int n = (lane >> 3) + 8 * j; const LAS float* sp = scr + (8 * c) * 33 + n;
        u32x4 o; o.x = pk2(sp[0 * 33], sp[1 * 33]); o.y = pk2(sp[2 * 33], sp[3 * 33]); o.z = pk2(sp[4 * 33], sp[5 * 33]); o.w = pk2(sp[6 * 33], sp[7 * 33]);
        *(u32x4*)(t.WT + (size_t)(r0 + n) * t.K + k0 + 8 * c) = o; }
    asm volatile("s_waitcnt lgkmcnt(0)" ::: "memory");
}
constexpr int WC_SLABS = 2 * NBS * 8;
typedef unsigned wcv4 __attribute__((ext_vector_type(4)));
#define WC_DECODE(s_) const int T_ = (s_) >> 10, b_ = ((s_) >> 3) & 127, k_ = (s_) & 7; \
        const int so_ = b_ * (WIN * KVW * 4) + k_ * 16384
#define WC_LOAD(pk_, s_, tid_, w) do { WC_DECODE(s_); const __amdgpu_buffer_rsrc_t r_ = MK_RSRC(T_ ? (pk_)->in[I_CV] : (pk_)->in[I_CK]); \
        w[0] = __builtin_amdgcn_raw_buffer_load_b128(r_, (tid_) * 16, so_ + DSEQ * KVW * 4, 2); \
        if (k_ < 7) w[1] = __builtin_amdgcn_raw_buffer_load_b128(r_, (tid_) * 16, so_ + DSEQ * KVW * 4 + 8192, 2); } while (0)
#define WC_STORE(pk_, s_, tid_, w) do { WC_DECODE(s_); const __amdgpu_buffer_rsrc_t r_ = MK_RSRC((pk_)->out); const int do_ = so_ + (T_ ? O_V_S : O_K_S) * 4; \
        __builtin_amdgcn_raw_buffer_store_b128(w[0], r_, (tid_) * 16, do_, 2); \
        if (k_ < 7) __builtin_amdgcn_raw_buffer_store_b128(w[1], r_, (tid_) * 16, do_ + 8192, 2); } while (0)
template <class PK> __device__ __forceinline__ void mod_phase(PK pk_, LAS unsigned char* L, float* mod, long gt, long GT) {
    struct { const float* in[22]; } p; p.in[I_WADA] = (const float*)pk_->in[I_WADA]; p.in[I_CP] = (const float*)pk_->in[I_CP]; p.in[I_CS] = (const float*)pk_->in[I_CS]; p.in[I_BADA] = (const float*)pk_->in[I_BADA];
    constexpr int WT_PITCH = 2064, WT_BYTES = 32 * WT_PITCH, AS_PITCH = 272, AS_BYTES = 144 * AS_PITCH;
    static_assert(WT_BYTES + 2 * AS_BYTES <= MISC_OFF, "mod LDS");
    int tid = threadIdx.x; asm volatile("" : "+v"(tid));
    const int lane = tid & 63, wave = __builtin_amdgcn_readfirstlane(tid >> 6), fr = lane & 15, fq = lane >> 4;
    const float* w_ada = p.in[I_WADA];
    for (int cgp = blockIdx.x; cgp < 256; cgp += gridDim.x) {
        __syncthreads();
        f32x4 wv[12];
#pragma unroll
        for (int i = 0; i < 12; ++i) { const int q = tid + 512 * i, k = q / 6, c4 = q % 6; wv[i] = NT_LD((const f32x4*)(w_ada + (size_t)k * (6 * D) + cgp * 24 + 4 * c4)); }
        f32x4 cv0[9], cv1[9];
        const int aoff = (tid >> 5) * (D * 4) + (tid & 31) * 16, a0off = aoff - (wave >= 4 ? NBP * D * 4 : 0);
        const __amdgpu_buffer_rsrc_t rcs = MK_RSRC(p.in[I_CS]), rc0 = MK_RSRC(wave < 4 ? p.in[I_CP] : p.in[I_CS]);
#define MOD_LOADA(cv, k0) do { cv[0] = __builtin_bit_cast(f32x4, __builtin_amdgcn_raw_buffer_load_b128(rc0, a0off, (k0) * 4, 0)); \
            _Pragma("unroll") for (int i = 1; i < 9; ++i) \
                if (i < 8 || tid < NBATCH * 32 - 4096) cv[i] = __builtin_bit_cast(f32x4, __builtin_amdgcn_raw_buffer_load_b128(rcs, aoff, (16 * i - NBP) * D * 4 + (k0) * 4, 0)); } while (0)
#define MOD_STOREA(cv, buf) do { _Pragma("unroll") for (int i = 0; i < 9; ++i) { const int f = tid + 512 * i, row = f >> 5, c4 = f & 31; \
            if (f < NBATCH * 32) { f32x4 v = cv[i]; _Pragma("unroll") for (int e = 0; e < 4; ++e) v[e] = v[e] * sigmoidf_(v[e]); \
                *(LAS u32x2*)(L + WT_BYTES + (buf) * AS_BYTES + row * AS_PITCH + c4 * 8) = (u32x2){cvtpk_s(v[0], v[1]), cvtpk_s(v[2], v[3])}; } } } while (0)
        MOD_LOADA(cv0, 0);
        MOD_LOADA(cv1, 128);
#pragma unroll
        for (int i = 0; i < 12; ++i) { const int q = tid + 512 * i, k = q / 6, c4 = q % 6;
#pragma unroll
            for (int e = 0; e < 4; ++e) *(LAS bf16_t*)(L + (4 * c4 + e) * WT_PITCH + k * 2) = (bf16_t)f2bf(wv[i][e]); }
        MOD_STOREA(cv0, 0);
        __syncthreads();
        f32x4 acc[2][2];
#pragma unroll
        for (int a = 0; a < 2; ++a)
#pragma unroll
            for (int b = 0; b < 2; ++b) acc[a][b] = (f32x4){0.f, 0.f, 0.f, 0.f};
        wcv4 wca[2], wcb[2];
        const bool docopy = cgp == (int)blockIdx.x;
#define MOD_CHUNK(ch, cvn, cvf, wl, ws_) do { \
            if (docopy) { const int s1_ = (int)blockIdx.x + (int)gridDim.x * (ch), s0_ = s1_ - (int)gridDim.x; \
                if (s1_ < WC_SLABS) WC_LOAD(pk_, s1_, tid, wl); \
                if ((ch) > 0 && s0_ < WC_SLABS) WC_STORE(pk_, s0_, tid, ws_); } \
            if ((ch) + 2 < D / 128) { MOD_LOADA(cvf, ((ch) + 2) * 128); } __builtin_amdgcn_sched_barrier(0); \
            const LAS unsigned char* As = L + WT_BYTES + ((ch) & 1) * AS_BYTES; \
            _Pragma("unroll") for (int ks = 0; ks < 4; ++ks) { \
                const bf16x8 b0 = *(const LAS bf16x8*)(L + fr * WT_PITCH + ((ch) * 128 + ks * 32 + fq * 8) * 2), b1 = *(const LAS bf16x8*)(L + (16 + fr) * WT_PITCH + ((ch) * 128 + ks * 32 + fq * 8) * 2); \
                const bf16x8 a0 = *(const LAS bf16x8*)(As + (wave * 16 + fr) * AS_PITCH + ks * 64 + fq * 16); \
                acc[0][0] = __builtin_amdgcn_mfma_f32_16x16x32_bf16(a0, b0, acc[0][0], 0, 0, 0); \
                acc[0][1] = __builtin_amdgcn_mfma_f32_16x16x32_bf16(a0, b1, acc[0][1], 0, 0, 0); \
                if (wave == 0) { const bf16x8 a1 = *(const LAS bf16x8*)(As + (128 + fr) * AS_PITCH + ks * 64 + fq * 16); \
                    acc[1][0] = __builtin_amdgcn_mfma_f32_16x16x32_bf16(a1, b0, acc[1][0], 0, 0, 0); \
                    acc[1][1] = __builtin_amdgcn_mfma_f32_16x16x32_bf16(a1, b1, acc[1][1], 0, 0, 0); } } \
            if ((ch) + 1 < D / 128) MOD_STOREA(cvn, ((ch) + 1) & 1); \
            __syncthreads(); } while (0)
#pragma unroll 1
        for (int c2 = 0; c2 < D / 128; c2 += 2) { MOD_CHUNK(c2, cv1, cv0, wca, wcb); MOD_CHUNK(c2 + 1, cv0, cv1, wcb, wca); }
        if (docopy) { const int s0_ = (int)blockIdx.x + (int)gridDim.x * (D / 128 - 1); if (s0_ < WC_SLABS) WC_STORE(pk_, s0_, tid, wcb); }
#undef MOD_CHUNK
#undef MOD_LOADA
#undef MOD_STOREA
        int tid2 = threadIdx.x; asm volatile("" : "+v"(tid2));
        const int fr2 = tid2 & 15, fq2 = (tid2 >> 4) & 3;
#pragma unroll
        for (int a = 0; a < 2; ++a) { if (a == 1 && wave != 0) continue; const int rb = a == 0 ? wave : 8;
#pragma unroll
            for (int nb = 0; nb < 2; ++nb) { const int cc = 16 * nb + fr2; if (cc < 24) { const float bb = p.in[I_BADA][cgp * 24 + cc];
#pragma unroll
                for (int reg = 0; reg < 4; ++reg) { const int row = rb * 16 + 4 * fq2 + reg; if (row < NBATCH) mod[(size_t)row * (6 * D) + cgp * 24 + cc] = acc[a][nb][reg] + bb; } } } }
    }
    __syncthreads();
}
namespace att {
constexpr int SLOT = 8192, NSLOT = 6;
constexpr int L_K = 0, L_V = NSLOT * SLOT, L_WS = 2 * NSLOT * SLOT, L_OST = L_WS + 2048, L_END = L_OST + NWAVES * 4096;
static_assert(L_END <= MISC_OFF, "attention LDS");
constexpr float NEG = -1e30f;
__device__ __forceinline__ int crow(int r, int hi) { return (r & 3) + 8 * (r >> 2) + 4 * hi; }
typedef short v4i16_t __attribute__((ext_vector_type(4)));
__device__ __forceinline__ s16x4 vtr(const LAS char* p) { return __builtin_bit_cast(s16x4, __builtin_amdgcn_ds_read_tr16_b64_v4i16((LAS v4i16_t*)p)); }

__device__ __forceinline__ void attn_sub(const LAS char* Kb, const LAS char* Vb, int t0, const bf16x8 (&qr)[4], int qi, int jmin, float slope2, float sink2,
                                         f32x16 (&o)[2], float& l_out, int lane) {
    const int r32 = lane & 31, hi = lane >> 5;
    const int lo = qi > jmin ? qi : jmin, hiq = qi + WIN;
    f32x16 P[3][2];
#pragma unroll
    for (int tt = 0; tt < 3; ++tt) {
        const int jb = 64 * (t0 + tt) + 4 * hi; const float A = slope2 * (float)(jb - WIN - qi);
        const int lo_rel = lo - jb, hi_rel = hiq - jb;
#pragma unroll
        for (int r = 0; r < 16; ++r) { const int off = (r & 3) + 8 * (r >> 2);
            float b0 = fmaf(slope2, (float)off, A), b1 = fmaf(slope2, (float)(off + 32), A);
            if (tt == 0 || (tt == 1 && jmin != 0)) { b0 = off >= lo_rel ? b0 : NEG; b1 = off + 32 >= lo_rel ? b1 : NEG; }
            if (tt == 2) { b0 = off <= hi_rel ? b0 : NEG; b1 = off + 32 <= hi_rel ? b1 : NEG; }
            P[tt][0][r] = b0; P[tt][1][r] = b1; }
        const LAS char* kp = Kb + (t0 + tt) * SLOT + hi * 1024 + r32 * 16;
#pragma unroll
        for (int d0 = 0; d0 < 4; ++d0) {
            const bf16x8 b0 = *(const LAS bf16x8*)(kp + d0 * 2048), b1 = *(const LAS bf16x8*)(kp + d0 * 2048 + 512);
            P[tt][0] = __builtin_amdgcn_mfma_f32_32x32x16_bf16(b0, qr[d0], P[tt][0], 0, 0, 0);
            P[tt][1] = __builtin_amdgcn_mfma_f32_32x32x16_bf16(b1, qr[d0], P[tt][1], 0, 0, 0);
        }
    }
    float m = sink2;
#pragma unroll
    for (int tt = 0; tt < 3; ++tt)
#pragma unroll
        for (int r = 0; r < 16; ++r) m = fmaxf(m, fmaxf(P[tt][0][r], P[tt][1][r]));
    m = fmaxf(m, __shfl_xor(m, 32));
    float l = hi == 0 ? __builtin_amdgcn_exp2f(sink2 - m) : 0.f;
#pragma unroll
    for (int r = 0; r < 16; ++r) { o[0][r] = 0.f; o[1][r] = 0.f; }
    const int voff = ((lane >> 4) & 1) * 32 + (lane & 3) * 8 + (4 * hi + ((lane & 15) >> 2)) * 64;
#pragma unroll
    for (int tt = 0; tt < 3; ++tt) {
        float sum = 0.f;
#pragma unroll
        for (int r = 0; r < 16; ++r) { P[tt][0][r] = __builtin_amdgcn_exp2f(P[tt][0][r] - m); P[tt][1][r] = __builtin_amdgcn_exp2f(P[tt][1][r] - m); sum += P[tt][0][r] + P[tt][1][r]; }
        l += sum;
        u32x4 pw[4];
#pragma unroll
        for (int k = 0; k < 4; ++k) { pw[0][k] = cvtpk_s(P[tt][0][2 * k], P[tt][0][2 * k + 1]); pw[1][k] = cvtpk_s(P[tt][0][8 + 2 * k], P[tt][0][9 + 2 * k]);
                                      pw[2][k] = cvtpk_s(P[tt][1][2 * k], P[tt][1][2 * k + 1]); pw[3][k] = cvtpk_s(P[tt][1][8 + 2 * k], P[tt][1][9 + 2 * k]); }
        const LAS char* vp = Vb + (t0 + tt) * SLOT + voff;
#pragma unroll
        for (int d0 = 0; d0 < 2; ++d0)
#pragma unroll
            for (int ks = 0; ks < 4; ++ks) {
                const s16x4 lo4 = vtr(vp + d0 * 4096 + ks * 1024), hh = vtr(vp + d0 * 4096 + ks * 1024 + 512);
                const bf16x8 vf = {lo4[0], lo4[1], lo4[2], lo4[3], hh[0], hh[1], hh[2], hh[3]};
                o[d0] = __builtin_amdgcn_mfma_f32_32x32x16_bf16(__builtin_bit_cast(bf16x8, pw[ks]), vf, o[d0], 0, 0, 0);
            }
    }
    l_out = l + __shfl_xor(l, 32);
}
}

#define K_Wup ((bf16_t*)(ws + WS_WUP))
#define K_Wdn ((bf16_t*)(ws + WS_WDN))
#define K_Win ((bf16_t*)(ws + WS_WIN))
#define K_Wc ((bf16_t*)(ws + WS_WC))
#define K_Wa ((bf16_t*)(ws + WS_WA))
#define K_Wm ((bf16_t*)(ws + WS_WM))
#define K_Ub ((bf16_t*)(ws + WS_U))
#define K_BGb ((bf16_t*)(ws + WS_BG))
#define K_Qb ((bf16_t*)(ws + WS_Q))
#define K_SAb ((bf16_t*)(ws + WS_SA))
#define K_SBb ((bf16_t*)(ws + WS_SB))
#define K_Kb ((bf16_t*)(ws + WS_K))
#define K_Vb ((bf16_t*)(ws + WS_V))
#define K_H2 ((bf16_t*)(ws + WS_U))
#define K_VLb ((bf16_t*)(ws + WS_VAL))
#define K_H1 ((bf16_t*)((float*)pk->out + O_Y))
#define K_X1 ((bf16_t*)(ws + WS_Q))
#define K_OUT ((float*)pk->out + O_Y)
#define K_mod ((float*)(ws + WS_MOD))
__global__ void __launch_bounds__(NWAVES * 64, 2) fwd_kernel(KP p_unused) {
    extern __shared__ __attribute__((aligned(16))) unsigned char lds[];
    LAS unsigned char* L = (LAS unsigned char*)lds;
    volatile LAS unsigned* MISC = (volatile LAS unsigned*)(L + MISC_OFF);
    struct KPG { const float GAS* in[22]; float GAS* out; unsigned char GAS* ws; };
    typedef const KPG __attribute__((address_space(4))) CKP;
    const CKP* pk = (const CKP*)__builtin_amdgcn_kernarg_segment_ptr();
    unsigned char GAS* ws = pk->ws;
#define PHASE_BEGIN() do { asm volatile("" : "+s"(pk)); ws = pk->ws; asm volatile("" : "+s"(ws)); tid = threadIdx.x; asm volatile("" : "+v"(tid)); lane = tid & 63; gt = (long)blockIdx.x * 512 + tid; } while (0)
    int tid = threadIdx.x, lane = tid & 63; const int wave = __builtin_amdgcn_readfirstlane(tid >> 6);
    const int G = gridDim.x, bx = blockIdx.x;
    const int vcu = (G % 8 == 0) ? (bx % 8) * (G / 8) + bx / 8 : bx;
    if (tid < 32) MISC[tid] = 0u;
    __syncthreads();
    XcdBarrier bar = xcd_barrier_post((unsigned*)ws + CW_BAR, MISC + 8);
    const int gw = vcu * NWAVES + wave, NGW = G * NWAVES;
    long gt = (long)bx * 512 + tid; const long GT = (long)G * 512;

    mod_phase(pk, L, K_mod, gt, GT);
    asm volatile("s_waitcnt vmcnt(0)" ::: "memory"); __syncthreads();
    if (tid == 0) { __builtin_amdgcn_fence(__ATOMIC_RELEASE, "agent"); asm volatile("s_waitcnt vmcnt(0)" ::: "memory"); (void)xb_add((unsigned*)ws + CW_MODCNT, 1u); }
    {
        LAS float* scr = (LAS float*)(L + wave * 16384);
        constexpr int I_IN = (D / 64) * (NIN / 32), I_SQ = (D / 64) * (D / 32), I_UP = (D / 64) * (NUP / 32), I_DN = (DFF / 64) * (D / 32);
        constexpr int NITEMS = I_IN + 3 * I_SQ + I_UP + I_DN;
        auto pick = [&](int it, TItem& t) {
            int r = it;
            if (r < I_IN) { t = TItem{((const float*)pk->in[I_WIN]), K_Win, D, NIN, 1, r}; return; } r -= I_IN;
            if (r < I_SQ) { t = TItem{((const float*)pk->in[I_WCO]), K_Wc, D, D, 0, r}; return; } r -= I_SQ;
            if (r < I_SQ) { t = TItem{((const float*)pk->in[I_WAO]), K_Wa, D, D, 0, r}; return; } r -= I_SQ;
            if (r < I_SQ) { t = TItem{((const float*)pk->in[I_WMIX]), K_Wm, D, D, 0, r}; return; } r -= I_SQ;
            if (r < I_UP) { t = TItem{((const float*)pk->in[I_WUP]), K_Wup, D, NUP, 2, r}; return; } r -= I_UP;
            t = TItem{((const float*)pk->in[I_WDN]), K_Wdn, DFF, D, 0, r}; };
        float tva[32], tvb[32]; TItem ta, tb;
        int it = gw;
        if (it < NITEMS) { pick(it, ta); titem_load(ta, lane, tva); }
        while (it < NITEMS) {
            const int it2 = it + NGW;
            if (it2 < NITEMS) { pick(it2, tb); titem_load(tb, lane, tvb); }
            __builtin_amdgcn_sched_barrier(0);
            titem_finish(ta, lane, tva, scr);
            if (it2 >= NITEMS) break;
            const int it3 = it2 + NGW;
            if (it3 < NITEMS) { pick(it3, ta); titem_load(ta, lane, tva); }
            __builtin_amdgcn_sched_barrier(0);
            titem_finish(tb, lane, tvb, scr);
            it = it3;
        }
        for (int s_ = bx + G * (D / 128); s_ < WC_SLABS; s_ += G) { wcv4 w_[2]; WC_LOAD(pk, s_, tid, w_); WC_STORE(pk, s_, tid, w_); }
    }
    if (tid == 0) { unsigned* cw = (unsigned*)ws + CW_MODCNT; unsigned* tm = (unsigned*)ws + CW_BAR + XB_TMO; unsigned sp = 0;
        while (xb_ld(cw) < (unsigned)G) { __builtin_amdgcn_s_sleep(2); if ((++sp & 255u) == 0u) { if (xb_ld(tm)) break; if (sp > XB_SPIN_CAP) { atomicAdd(tm, 1u); break; } } }
        __builtin_amdgcn_fence(__ATOMIC_ACQUIRE, "agent"); asm volatile("s_waitcnt vmcnt(0)" ::: "memory"); }
    __syncthreads();

    {
        const int rpw = (M + NGW - 1) / NGW, m0 = gw * rpw, m1 = (m0 + rpw < M) ? m0 + rpw : M;
        f32x4 ga[4], ca[4], ha[4], xv[4], xn[4]; int curb = -1;
#pragma unroll
        for (int j = 0; j < 4; ++j) ga[j] = ((const f32x4*)((const float*)pk->in[I_N1G]))[lane + 64 * j];
        auto xrow = [&](int m) { return (const f32x4*)(m < MP ? ((const float*)pk->in[I_XP]) + (size_t)m * D : ((const float*)pk->in[I_XS]) + (size_t)(m - MP) * D) + lane; };
        if (m0 < m1) { const f32x4* xr = xrow(m0);
#pragma unroll
            for (int j = 0; j < 4; ++j) xv[j] = __builtin_nontemporal_load(xr + 64 * j); }
        for (int m = m0; m < m1; ++m) {
            if (m + 1 < m1) { const f32x4* xr = xrow(m + 1);
#pragma unroll
                for (int j = 0; j < 4; ++j) xn[j] = __builtin_nontemporal_load(xr + 64 * j); }
            __builtin_amdgcn_sched_barrier(0);
            const int b = row_batch(m);
            if (b != curb) { curb = b; const float* md = K_mod + (size_t)b * (6 * D);
#pragma unroll
                for (int j = 0; j < 4; ++j) { ca[j] = ((const f32x4*)(md + D))[lane + 64 * j] + 1.0f; ha[j] = ((const f32x4*)md)[lane + 64 * j]; } }
            float ss = 0.f;
#pragma unroll
            for (int j = 0; j < 4; ++j) ss += (xv[j].x * xv[j].x + xv[j].y * xv[j].y) + (xv[j].z * xv[j].z + xv[j].w * xv[j].w);
            const float rstd = 1.0f / sqrtf(wave_sum(ss) * (1.f / D) + RMS_EPS);
            unsigned long long* o8 = (unsigned long long*)(K_H1 + (size_t)m * D) + lane;
#pragma unroll
            for (int j = 0; j < 4; ++j) { const f32x4 y = xv[j] * rstd * ga[j] * ca[j] + ha[j];
                o8[64 * j] = (unsigned long long)pk2(y.x, y.y) | ((unsigned long long)pk2(y.z, y.w) << 32); }
#pragma unroll
            for (int j = 0; j < 4; ++j) xv[j] = xn[j];
        }
    }
    xcd_barrier(bar);
    PHASE_BEGIN();

    { SchedPlain S{(const char*)K_H1, (const char*)K_Win, M / 256, NIN / 256, G, bx, (size_t)256 * D * 2};
      EpiG1 E{K_Ub, K_BGb, K_Qb, K_Kb, K_Vb, K_SAb, K_SBb, ((float*)pk->out)};
      pg8::gemm_phase<EpiG1, SchedPlain, false>(L, D, S, E); }
    xcd_barrier(bar);
    PHASE_BEGIN();

    {
        using namespace att;
        const LAS char* Kl = (const LAS char*)(L + L_K); const LAS char* Vl = (const LAS char*)(L + L_V);
        LAS float* wsf = (LAS float*)(L + L_WS) + wave * 64;
        LAS bf16_t* stg = (LAS bf16_t*)(L + L_OST) + wave * 2048;
        const int r32 = lane & 31, hi = lane >> 5;
        const float* sinks = ((const float*)pk->in[I_SINK]);
        for (int un_ = vcu; un_ < 512 + 256; un_ += G) { const int un = un_ < 256 ? 512 + un_ : un_ - 256;
            __syncthreads();
            if (un < 512) {
                const int b = un >> 6, kvh = (un >> 4) & 3, qb = un & 15;
                const long row0 = (long)b * SEQ + qb * WIN - WIN;
                {
                    u32x4 kv[4], vv[4];
#pragma unroll
                    for (int s = 0; s < 4; ++s) { const long kr = row0 + 64 * s + lane; const long vr = row0 + 64 * s + 16 * (wave & 3) + (lane >> 2);
                        kv[s] = (u32x4){0u, 0u, 0u, 0u}; vv[s] = (u32x4){0u, 0u, 0u, 0u};
                        if (qb > 0 || s >= 2) { kv[s] = *(const u32x4*)(K_Kb + (size_t)kr * KVW + kvh * 64 + wave * 8);
                                                vv[s] = *(const u32x4*)(K_Vb + (size_t)vr * KVW + kvh * 64 + (wave >> 2) * 32 + (lane & 3) * 8); } }
#pragma unroll
                    for (int s = 0; s < 4; ++s) { *(LAS u32x4*)(L + L_K + s * SLOT + wave * 1024 + lane * 16) = kv[s]; *(LAS u32x4*)(L + L_V + s * SLOT + wave * 1024 + lane * 16) = vv[s]; }
                }
                __syncthreads();
                const int g = wave >> 1, rh = wave & 1, head = kvh * 4 + g;
                const float slope2 = __builtin_amdgcn_exp2f(-0.5f * (float)(head + 1)) * LOG2E, sink2 = sinks[head] * LOG2E;
#pragma unroll 1
                for (int sb = 0; sb < 2; ++sb) {
                    const int i0 = 64 * rh + 32 * sb; const long qrow = (long)b * SEQ + qb * WIN + i0;
                    bf16x8 qr[4];
#pragma unroll
                    for (int d0 = 0; d0 < 4; ++d0) qr[d0] = *(const bf16x8*)(K_Qb + (size_t)(qrow + r32) * D + head * 64 + d0 * 16 + hi * 8);
                    f32x16 o[2]; float lt;
                    attn_sub(Kl, Vl, i0 >= 64 ? 1 : 0, qr, i0 + r32, qb == 0 ? WIN : 0, slope2, sink2, o, lt, lane);
                    if (hi == 0) wsf[32 + r32] = lt;
                    asm volatile("s_waitcnt lgkmcnt(0)" ::: "memory");
#pragma unroll
                    for (int r = 0; r < 16; ++r) { const int orow = crow(r, hi); const float rl = __builtin_amdgcn_rcpf(wsf[32 + orow]);
                        stg[orow * 64 + r32] = (bf16_t)f2bf(o[0][r] * rl); stg[orow * 64 + 32 + r32] = (bf16_t)f2bf(o[1][r] * rl); }
                    asm volatile("s_waitcnt lgkmcnt(0)" ::: "memory");
#pragma unroll
                    for (int i = 0; i < 4; ++i) { const int row = i * 8 + (lane >> 3), ch = lane & 7; const u32x4 v = *(const LAS u32x4*)(stg + row * 64 + ch * 8);
                        *(u32x4*)(K_Qb + (size_t)(qrow + row) * D + head * 64 + ch * 8) = v; }
                    asm volatile("s_waitcnt lgkmcnt(0)" ::: "memory");
                }
            } else {
                const int u2 = un - 512;
#pragma unroll
                for (int ti = 0; ti < 2; ++ti) { const int task = 2 * u2 + ti, b = task >> 2, kvh = task & 3;
                    const float* ck = ((const float*)pk->in[I_CK]) + (size_t)b * WIN * KVW + kvh * 64; const float* cv = ((const float*)pk->in[I_CV]) + (size_t)b * WIN * KVW + kvh * 64;
                    const int vc = (wave >> 2) * 32 + (lane & 3) * 8;
                    f32x4 ka[2][2], va[2][2]; u32x4 kn = {0u, 0u, 0u, 0u}, vn = {0u, 0u, 0u, 0u};
#pragma unroll
                    for (int s = 0; s < 2; ++s) { const int kk = 64 * s + lane, vk = 64 * s + 16 * (wave & 3) + (lane >> 2);
                        ka[s][0] = NT_LD((const f32x4*)(ck + (size_t)kk * KVW + wave * 8)); ka[s][1] = NT_LD((const f32x4*)(ck + (size_t)kk * KVW + wave * 8 + 4));
                        va[s][0] = NT_LD((const f32x4*)(cv + (size_t)vk * KVW + vc)); va[s][1] = NT_LD((const f32x4*)(cv + (size_t)vk * KVW + vc + 4)); }
                    if (lane < DSEQ) kn = *(const u32x4*)(K_Kb + (size_t)(MP + b * DSEQ + lane) * KVW + kvh * 64 + wave * 8);
                    { const int vk = 16 * (wave & 3) + (lane >> 2); if (vk < DSEQ) vn = *(const u32x4*)(K_Vb + (size_t)(MP + b * DSEQ + vk) * KVW + kvh * 64 + vc); }
#pragma unroll
                    for (int s = 0; s < 2; ++s) {
                        *(LAS u32x4*)(L + L_K + (3 * ti + s) * SLOT + wave * 1024 + lane * 16) = (u32x4){pk2(ka[s][0].x, ka[s][0].y), pk2(ka[s][0].z, ka[s][0].w), pk2(ka[s][1].x, ka[s][1].y), pk2(ka[s][1].z, ka[s][1].w)};
                        *(LAS u32x4*)(L + L_V + (3 * ti + s) * SLOT + wave * 1024 + lane * 16) = (u32x4){pk2(va[s][0].x, va[s][0].y), pk2(va[s][0].z, va[s][0].w), pk2(va[s][1].x, va[s][1].y), pk2(va[s][1].z, va[s][1].w)}; }
                    *(LAS u32x4*)(L + L_K + (3 * ti + 2) * SLOT + wave * 1024 + lane * 16) = kn; *(LAS u32x4*)(L + L_V + (3 * ti + 2) * SLOT + wave * 1024 + lane * 16) = vn; }
                __syncthreads();
                if (wave < 2) { const int task = 2 * u2 + wave, b = task >> 2, kvh = task & 3;
                    const int head = kvh * 4 + (r32 >> 3), tq = r32 & 7; const long qrow = MP + (long)b * DSEQ + tq;
                    const float slope2 = __builtin_amdgcn_exp2f(-0.5f * (float)(head + 1)) * LOG2E, sink2 = sinks[head] * LOG2E;
                    bf16x8 qr[4];
#pragma unroll
                    for (int d0 = 0; d0 < 4; ++d0) qr[d0] = *(const bf16x8*)(K_Qb + (size_t)qrow * D + head * 64 + d0 * 16 + hi * 8);
                    f32x16 o[2]; float lt;
                    attn_sub(Kl + 3 * wave * SLOT, Vl + 3 * wave * SLOT, 0, qr, tq, 0, slope2, sink2, o, lt, lane);
                    if (hi == 0) wsf[32 + r32] = lt;
                    asm volatile("s_waitcnt lgkmcnt(0)" ::: "memory");
#pragma unroll
                    for (int r = 0; r < 16; ++r) { const int orow = crow(r, hi); const float rl = __builtin_amdgcn_rcpf(wsf[32 + orow]);
                        stg[orow * 64 + r32] = (bf16_t)f2bf(o[0][r] * rl); stg[orow * 64 + 32 + r32] = (bf16_t)f2bf(o[1][r] * rl); }
                    asm volatile("s_waitcnt lgkmcnt(0)" ::: "memory");
#pragma unroll
                    for (int i = 0; i < 4; ++i) { const int row = i * 8 + (lane >> 3), ch = lane & 7; const u32x4 v = *(const LAS u32x4*)(stg + row * 64 + ch * 8);
                        *(u32x4*)(K_Qb + (size_t)(MP + (long)b * DSEQ + (row & 7)) * D + (kvh * 4 + (row >> 3)) * 64 + ch * 8) = v; }
                    asm volatile("s_waitcnt lgkmcnt(0)" ::: "memory");
                }
            }
        }
        {
            const float* cw = ((const float*)pk->in[I_CONVW]);
            const int c0 = (int)(gt & 127) * 8; const int nrb = (int)(GT >> 7), rb = (int)(gt >> 7);
            const int rpb = (M + nrb - 1) / nrb, r0 = rb * rpb, r1 = (r0 + rpb < M) ? r0 + rpb : M;
            const f32x4 w0a = *(const f32x4*)(cw + c0), w0b = *(const f32x4*)(cw + c0 + 4), w1a = *(const f32x4*)(cw + D + c0), w1b = *(const f32x4*)(cw + D + c0 + 4),
                        w2a = *(const f32x4*)(cw + 2 * D + c0), w2b = *(const f32x4*)(cw + 2 * D + c0 + 4);
            f32x4 p1a = {0.f, 0.f, 0.f, 0.f}, p1b = p1a, p2a = p1a, p2b = p1a;
            auto unp = [](const u32x4 w, f32x4& a, f32x4& b) { a = (f32x4){bflo(w.x), bfhi(w.x), bflo(w.y), bfhi(w.y)}; b = (f32x4){bflo(w.z), bfhi(w.z), bflo(w.w), bfhi(w.w)}; };
            if (r0 < r1) { const int t0 = r0 < MP ? (r0 & 2047) : ((r0 - MP) & 7);
                if (t0 >= 1) unp(*(const u32x4*)(K_Ub + (size_t)(r0 - 1) * D + c0), p1a, p1b);
                if (t0 >= 2) unp(*(const u32x4*)(K_Ub + (size_t)(r0 - 2) * D + c0), p2a, p2b);
                else if (t0 == 1 && r0 >= MP) { const float* sc = ((const float*)pk->in[I_SCONV]) + ((size_t)((r0 - MP) >> 3) * 2 + 1) * D + c0; p2a = *(const f32x4*)sc; p2b = *(const f32x4*)(sc + 4); } }
            u32x4 un = {0u, 0u, 0u, 0u}, gn = un;
            if (r0 < r1) { un = NT_LD((const u32x4*)(K_Ub + (size_t)r0 * D + c0)); gn = NT_LD((const u32x4*)(K_BGb + (size_t)r0 * D + c0)); }
            for (int row = r0; row < r1; ++row) {
                const u32x4 uw = un, gw4 = gn;
                if (row + 1 < r1) { un = NT_LD((const u32x4*)(K_Ub + (size_t)(row + 1) * D + c0)); gn = NT_LD((const u32x4*)(K_BGb + (size_t)(row + 1) * D + c0)); }
                __builtin_amdgcn_sched_barrier(0);
                const bool samp = row >= MP; const int t = samp ? ((row - MP) & 7) : (row & 2047);
                if (t == 0) { if (samp) { const float* sc = ((const float*)pk->in[I_SCONV]) + (size_t)((row - MP) >> 3) * 2 * D + c0; p2a = *(const f32x4*)sc; p2b = *(const f32x4*)(sc + 4); p1a = *(const f32x4*)(sc + D); p1b = *(const f32x4*)(sc + D + 4); }
                              else { p1a = (f32x4){0.f, 0.f, 0.f, 0.f}; p1b = p1a; p2a = p1a; p2b = p1a; } }
                f32x4 xa, xb, ga, gb; unp(uw, xa, xb); unp(gw4, ga, gb);
                const f32x4 ya = ga * (w0a * p2a + w1a * p1a + w2a * xa), yb = gb * (w0b * p2b + w1b * p1b + w2b * xb);
                *(u32x4*)(K_BGb + (size_t)row * D + c0) = (u32x4){pk2(ya[0], ya[1]), pk2(ya[2], ya[3]), pk2(yb[0], yb[1]), pk2(yb[2], yb[3])};
                p2a = p1a; p2b = p1b; p1a = xa; p1b = xb;
            }
        }
    }
    xcd_barrier(bar);
    PHASE_BEGIN();

    { SchedPair S{(const char*)K_Qb, (const char*)K_Wa, (const char*)K_BGb, (const char*)K_Wc, MP / 256, D / 256, G, bx, (size_t)256 * D * 2};
      EpiG2 E{K_SAb, K_SBb, K_SAb};
      pg8::gemm_phase<EpiG2, SchedPair, true>(L, D, S, E); }
    xcd_barrier(bar);
    PHASE_BEGIN();

    { SchedPlain S{(const char*)K_SAb, (const char*)K_Wm, MP / 256, D / 256, G, bx, (size_t)256 * D * 2};
      EpiG3N E{((const float*)pk->in[I_XP]), ((const float*)pk->in[I_XS]), K_X1, K_H2, K_mod, ((const float*)pk->in[I_N2G]), RowStat{(float*)(ws + WS_SLOT3), (unsigned*)ws + CW_CNT3, (unsigned*)ws + CW_BAR + XB_TMO, (LAS float*)(L + TAB_OFF)}};
      pg8::gemm_phase<EpiG3N, SchedPlain, true>(L, D, S, E); }
    xcd_barrier(bar);
    PHASE_BEGIN();

    { SchedPlain S{(const char*)K_H2, (const char*)K_Wup, M / 256, NUP / 256, G, bx, (size_t)256 * D * 2};
      EpiG4F E{K_VLb, ((float*)pk->out), (float*)(ws + WS_SIDEL), (float*)(ws + WS_SIDEF), ((const float*)pk->in[I_FCW]), ((const float*)pk->in[I_SFFN]), (LAS float*)(L + XL_OFF)};
      pg8::gemm_phase<EpiG4F, SchedPlain, false>(L, D, S, E); }
    xcd_barrier(bar);
    PHASE_BEGIN();

    for (long Lt = bx; Lt < 256; Lt += G) { int pm_, pn_; pg8::tile_of((int)Lt, MP / 256, D / 256, pm_, pn_);
        if ((pm_ & 7) != 0) ffn_fixup(pm_, K_VLb, (const float*)(ws + WS_SIDEL), (const float*)(ws + WS_SIDEF), ((const float*)pk->in[I_FCW])); }
    asm volatile("s_waitcnt vmcnt(0)" ::: "memory"); __syncthreads();
    { SchedPlain Sd{(const char*)K_VLb, (const char*)K_Wdn, MP / 256, D / 256, G, bx, (size_t)256 * DFF * 2};
      EpiG5N<true> E{K_X1, K_OUT, K_mod, ((const float*)pk->in[I_FING]), RowStat{(float*)(ws + WS_SLOT5), (unsigned*)ws + CW_CNT5, (unsigned*)ws + CW_BAR + XB_TMO, (LAS float*)(L + TAB_OFF)}, (const unsigned*)ws + CW_BAR + XB_TMO};
      pg8::gemm_phase<EpiG5N<true>, SchedPlain, true>(L, DFF, Sd, E); }
}

extern "C" void kernel_launch(void* const* d_in, const int* in_sizes, int n_in, void* d_out, int out_size, void* d_ws, size_t ws_size, hipStream_t stream) {
    static int grid = 0;
    if (grid == 0) {
        int dev = 0, cus = 0, per_cu = 0;
        if (n_in != 22 || out_size != (int)O_END || ws_size < WS_END) { fprintf(stderr, "kernel_launch: unexpected shapes (n_in %d out %d ws %zu)\n", n_in, out_size, ws_size); grid = -1; return; }
        if (hipGetDevice(&dev) != hipSuccess || hipDeviceGetAttribute(&cus, hipDeviceAttributeMultiprocessorCount, dev) != hipSuccess) { grid = -1; return; }
        if (hipFuncSetAttribute((const void*)fwd_kernel, hipFuncAttributeMaxDynamicSharedMemorySize, LDS_BYTES) != hipSuccess) { grid = -1; return; }
        if (hipOccupancyMaxActiveBlocksPerMultiprocessor(&per_cu, (const void*)fwd_kernel, NWAVES * 64, LDS_BYTES) != hipSuccess || per_cu < 1) { fprintf(stderr, "occupancy query: %d\n", per_cu); grid = -1; return; }
        grid = cus;
    }
    if (grid < 0) return;
    (void)hipMemsetAsync(d_ws, 0, CTL_BYTES, stream);
    KP p{};
    for (int i = 0; i < 22; ++i) p.in[i] = (const float*)d_in[i];
    p.out = (float*)d_out; p.ws = (unsigned char*)d_ws;
    void* args[] = {&p};
    hipError_t e = hipLaunchCooperativeKernel((const void*)fwd_kernel, dim3(grid), dim3(NWAVES * 64), args, LDS_BYTES, stream);
    if (e != hipSuccess) fprintf(stderr, "cooperative launch failed: %s\n", hipGetErrorString(e));
}
```
